# Optimizing an MI355X kernel written in HIP

```python
import math
import jax, jax.numpy as jnp
from jax import lax
import numpy as np

D_MODEL = 1024
BATCH = 32
SEQ = 2048
DEPTH = 2

N_MEM = 256
MIX_WIDTH = D_MODEL
HGRN_WIDTH = D_MODEL // 2
HGRN_HEAD_DIM = 128
HGRN_HEADS = HGRN_WIDTH // HGRN_HEAD_DIM
HGRN_CHUNK = 64
ATTN_WIDTH = MIX_WIDTH - HGRN_WIDTH
ATTN_HEAD_DIM = 64
ATTN_HEADS = ATTN_WIDTH // ATTN_HEAD_DIM
DILATED_PATTERNS = ((128, 1), (512, 4), (2048, 16))
ATTN_BLOCK = 64
MEM_HEADS = 4
MEM_HEAD_DIM = D_MODEL // MEM_HEADS
D_FF = 2816
FFN_RES = 0.5
EPS = 1e-6
IN_SPLITS = (HGRN_WIDTH, HGRN_WIDTH, HGRN_WIDTH, HGRN_WIDTH, HGRN_WIDTH,
             ATTN_WIDTH, ATTN_WIDTH, ATTN_WIDTH)
IN_COLS = sum(IN_SPLITS)

kernel_name = "hybrid_hgrn2_dilated_attn_macaron_encoder"


def rms_norm(x, g):
    xf = x.astype(jnp.float32)
    y = xf * lax.rsqrt(jnp.mean(xf * xf, axis=-1, keepdims=True) + EPS)
    return (y * g.astype(jnp.float32)).astype(x.dtype)


def swiglu(x, w_gate, w_up, w_down):
    return (jax.nn.silu(x @ w_gate) * (x @ w_up)) @ w_down


def alibi_slopes(n_heads):
    return jnp.asarray(np.array([2.0 ** (-8.0 * (h + 1) / n_heads) for h in range(n_heads)],
                                dtype=np.float32))


def hgrn2_chunk_scan(q, k, v, log_f):
    B, S, H, Dk = q.shape
    Dv = v.shape[-1]
    n_chunks = S // HGRN_CHUNK

    def to_chunks(a):
        return a.reshape(B, n_chunks, HGRN_CHUNK, H, a.shape[-1]).transpose(1, 0, 3, 2, 4)

    xs = tuple(to_chunks(a) for a in (q, k, v, log_f))
    causal_in_chunk = jnp.tril(jnp.ones((HGRN_CHUNK, HGRN_CHUNK), dtype=bool))[:, :, None]

    def step(state, inp):
        qc, kc, vc, gc = inp
        A = jnp.cumsum(gc, axis=2)
        diff = A[:, :, :, None, :] - A[:, :, None, :, :]
        decay = jnp.exp(jnp.where(causal_in_chunk, diff, -jnp.inf))
        scores = jnp.einsum('bhtk,bhsk,bhtsk->bhts', qc, kc, decay)
        o = (jnp.einsum('bhts,bhsv->bhtv', scores, vc)
             + jnp.einsum('bhtk,bhkv->bhtv', qc * jnp.exp(A), state))
        A_last = A[:, :, -1:, :]
        state = (jnp.exp(A_last[:, :, 0, :])[..., None] * state
                 + jnp.einsum('bhsk,bhsv->bhkv', kc * jnp.exp(A_last - A), vc))
        return state, o

    s0 = jnp.zeros((B, H, Dk, Dv), jnp.float32)
    _, o = lax.scan(step, s0, xs)
    return o.transpose(1, 0, 3, 2, 4).reshape(B, S, H, Dv)


def hgrn2_forget(z, lb):
    log_f = jnp.logaddexp(jnp.log(lb), jnp.log1p(-lb) + jax.nn.log_sigmoid(z))
    one_minus_f = (1.0 - lb) * jax.nn.sigmoid(-z)
    return log_f, one_minus_f


def hgrn2_mixer(q, i, z_fwd, z_bwd, g, lb_fwd, lb_bwd, out_gain):
    B, S, _ = q.shape
    heads = lambda a: a.astype(jnp.float32).reshape(B, S, HGRN_HEADS, HGRN_HEAD_DIM)
    qh, ih = heads(q), heads(i)
    lbf = lb_fwd.astype(jnp.float32).reshape(HGRN_HEADS, HGRN_HEAD_DIM)
    lbb = lb_bwd.astype(jnp.float32).reshape(HGRN_HEADS, HGRN_HEAD_DIM)
    logf_f, k_f = hgrn2_forget(heads(z_fwd), lbf)
    logf_b, k_b = hgrn2_forget(heads(z_bwd), lbb)
    o_f = hgrn2_chunk_scan(qh, k_f, ih, logf_f)
    flip = lambda a: jnp.flip(a, axis=1)
    o_b = flip(hgrn2_chunk_scan(flip(qh), flip(k_b), flip(ih), flip(logf_b)))
    o = o_f + o_b
    o = o * lax.rsqrt(jnp.mean(o * o, axis=-1, keepdims=True) + EPS)
    o = o * out_gain.astype(jnp.float32).reshape(HGRN_HEADS, HGRN_HEAD_DIM)
    o = o.reshape(B, S, HGRN_WIDTH) * jax.nn.silu(g.astype(jnp.float32))
    return o.astype(q.dtype)


def dilated_branch(q, k, v, window, dil, slopes):
    B, S, H, Dh = q.shape
    half = window // (2 * dil)
    blk = ATTN_BLOCK
    L = S // dil
    nb = -(-L // blk)
    Lp = nb * blk

    def split(a):
        return a.reshape(B, L, dil, H, Dh).transpose(0, 2, 3, 1, 4)

    qs, ks, vs = split(q), split(k), split(v)
    qb = jnp.pad(qs, ((0, 0), (0, 0), (0, 0), (0, Lp - L), (0, 0))).reshape(B, dil, H, nb, blk, Dh)

    def band(a):
        ap = jnp.pad(a, ((0, 0), (0, 0), (0, 0), (blk, Lp - L + blk), (0, 0)))
        ap = ap.reshape(B, dil, H, nb + 2, blk, Dh)
        return jnp.concatenate([ap[:, :, :, :-2], ap[:, :, :, 1:-1], ap[:, :, :, 2:]], axis=4)

    kw, vw = band(ks), band(vs)
    qpos = jnp.arange(Lp).reshape(nb, blk)
    kpos = (jnp.arange(nb)[:, None] - 1) * blk + jnp.arange(3 * blk)[None, :]
    rel = kpos[:, None, :] - qpos[:, :, None]
    valid = (jnp.abs(rel) <= half) & (kpos[:, None, :] >= 0) & ((kpos[:, None, :] < L) | (rel == 0))
    bias = -(slopes[:, None, None, None] * (dil * jnp.abs(rel)).astype(jnp.float32))

    s = jnp.einsum('brhnqe,brhnke->brhnqk', qb, kw) * (1.0 / math.sqrt(Dh)) + bias[None, None]
    s = jnp.where(valid, s, -jnp.inf)
    m = jnp.max(s, axis=-1, keepdims=True)
    p = jnp.exp(s - m)
    l = jnp.sum(p, axis=-1, keepdims=True)
    o = jnp.einsum('brhnqk,brhnke->brhnqe', p, vw) / l
    lse = (m + jnp.log(l))[..., 0]
    o = o.reshape(B, dil, H, Lp, Dh)[:, :, :, :L].transpose(0, 3, 1, 2, 4).reshape(B, S, H, Dh)
    lse = lse.reshape(B, dil, H, Lp)[:, :, :, :L].transpose(0, 3, 1, 2).reshape(B, S, H)
    return o, lse


def dilated_attention(q, k, v):
    B, S, _ = q.shape
    heads = lambda a: a.astype(jnp.float32).reshape(B, S, ATTN_HEADS, ATTN_HEAD_DIM)
    qh, kh, vh = heads(q), heads(k), heads(v)
    slopes = alibi_slopes(ATTN_HEADS)
    outs, lses = [], []
    for window, dil in DILATED_PATTERNS:
        o, lse = dilated_branch(qh, kh, vh, window, dil, slopes)
        outs.append(o)
        lses.append(lse)
    w = jax.nn.softmax(jnp.stack(lses, axis=0), axis=0)
    o = jnp.sum(w[..., None] * jnp.stack(outs, axis=0), axis=0)
    return o.reshape(B, S, ATTN_WIDTH).astype(q.dtype)


def memory_cross_attention(hn, memn, w_q, w_kv, w_o):
    B, S, _ = hn.shape
    M = memn.shape[1]
    q = (hn @ w_q).astype(jnp.float32).reshape(B, S, MEM_HEADS, MEM_HEAD_DIM)
    k, v = jnp.split((memn @ w_kv).astype(jnp.float32), 2, axis=-1)
    k = k.reshape(B, M, MEM_HEADS, MEM_HEAD_DIM)
    v = v.reshape(B, M, MEM_HEADS, MEM_HEAD_DIM)
    s = jnp.einsum('bshe,bmhe->bhsm', q, k) * (1.0 / math.sqrt(MEM_HEAD_DIM))
    p = jax.nn.softmax(s, axis=-1)
    o = jnp.einsum('bhsm,bmhe->bshe', p, v).reshape(B, S, D_MODEL).astype(hn.dtype)
    return o @ w_o


def setup_inputs(seed: int = 0) -> dict:
    key = jax.random.key(seed)
    ks = jax.random.split(key, 24)
    nrm = lambda k, shape, scale: jax.random.normal(k, shape, jnp.float32) * scale
    gain = lambda k, shape: 1.0 + 0.05 * jax.random.normal(k, shape, jnp.float32)
    D, F = D_MODEL, D_FF
    return {
        "x": nrm(ks[0], (BATCH, SEQ, D), 1.0),
        "mem": nrm(ks[1], (BATCH, N_MEM, D), 1.0),
        "ln_ffn1": gain(ks[2], (DEPTH, D)),
        "ffn1_w_gate": nrm(ks[3], (DEPTH, D, F), D ** -0.5),
        "ffn1_w_up": nrm(ks[4], (DEPTH, D, F), D ** -0.5),
        "ffn1_w_down": nrm(ks[5], (DEPTH, F, D), F ** -0.5),
        "ln_mix": gain(ks[6], (DEPTH, D)),
        "w_in": nrm(ks[7], (DEPTH, D, IN_COLS), D ** -0.5),
        "hgrn_lb_logits": nrm(ks[8], (DEPTH, 2, HGRN_WIDTH), 0.5),
        "hgrn_out_norm": gain(ks[9], (DEPTH, HGRN_WIDTH)),
        "w_out": nrm(ks[10], (DEPTH, MIX_WIDTH, D), MIX_WIDTH ** -0.5),
        "ln_xq": gain(ks[11], (DEPTH, D)),
        "ln_mem": gain(ks[12], (DEPTH, D)),
        "w_xq": nrm(ks[13], (DEPTH, D, D), D ** -0.5),
        "w_xkv": nrm(ks[14], (DEPTH, D, 2 * D), D ** -0.5),
        "w_xo": nrm(ks[15], (DEPTH, D, D), D ** -0.5),
        "ln_ffn2": gain(ks[16], (DEPTH, D)),
        "ffn2_w_gate": nrm(ks[17], (DEPTH, D, F), D ** -0.5),
        "ffn2_w_up": nrm(ks[18], (DEPTH, D, F), D ** -0.5),
        "ffn2_w_down": nrm(ks[19], (DEPTH, F, D), F ** -0.5),
        "ln_final": gain(ks[20], (D,)),
    }


def reference(x, mem, ln_ffn1, ffn1_w_gate, ffn1_w_up, ffn1_w_down, ln_mix, w_in,
              hgrn_lb_logits, hgrn_out_norm, w_out, ln_xq, ln_mem, w_xq, w_xkv, w_xo,
              ln_ffn2, ffn2_w_gate, ffn2_w_up, ffn2_w_down, ln_final):
    lb_all = jnp.cumsum(jax.nn.softmax(hgrn_lb_logits.astype(jnp.float32), axis=0), axis=0)
    lb_all = lb_all - lb_all[0:1]
    offsets = np.cumsum(IN_SPLITS)[:-1].tolist()
    h = x
    for l in range(DEPTH):
        h = h + FFN_RES * swiglu(rms_norm(h, ln_ffn1[l]), ffn1_w_gate[l], ffn1_w_up[l], ffn1_w_down[l])
        u = rms_norm(h, ln_mix[l])
        proj = u @ w_in[l]
        q_h, i_h, zf_h, zb_h, g_h, q_a, k_a, v_a = jnp.split(proj, offsets, axis=-1)
        y_h = hgrn2_mixer(q_h, i_h, zf_h, zb_h, g_h, lb_all[l, 0], lb_all[l, 1], hgrn_out_norm[l])
        y_a = dilated_attention(q_a, k_a, v_a)
        h = h + jnp.concatenate([y_h, y_a], axis=-1) @ w_out[l]
        h = h + memory_cross_attention(rms_norm(h, ln_xq[l]), rms_norm(mem, ln_mem[l]),
                                       w_xq[l], w_xkv[l], w_xo[l])
        h = h + FFN_RES * swiglu(rms_norm(h, ln_ffn2[l]), ffn2_w_gate[l], ffn2_w_up[l], ffn2_w_down[l])
    return rms_norm(h, ln_final)
```

```cpp
#include <hip/hip_runtime.h>
#include <hip/hip_cooperative_groups.h>
#include <cstdio>
namespace cg = cooperative_groups;

#define LAS __attribute__((address_space(3)))
typedef unsigned short bf16_t;
typedef short bf16x8 __attribute__((ext_vector_type(8)));
typedef short s16x4 __attribute__((ext_vector_type(4)));
typedef float f32x4 __attribute__((ext_vector_type(4)));
typedef unsigned u32x4 __attribute__((ext_vector_type(4)));
typedef unsigned u32x2 __attribute__((ext_vector_type(2)));
typedef unsigned char uchar;

constexpr int D_MODEL = 1024, BATCH = 32, SEQ = 2048, NTOK = BATCH * SEQ, N_MEM = 256, D_FF = 2816, IN_COLS = 4096;
constexpr float EPS = 1e-6f;
constexpr int LDS_BYTES = 147456;

constexpr size_t WS_HB   = 0;
constexpr size_t WS_BIG  = WS_HB + (size_t)NTOK * 1024 * 2;
constexpr size_t WS_Y    = WS_BIG + (size_t)NTOK * 4096 * 2;
constexpr size_t WS_MEMB = WS_Y + (size_t)NTOK * 1024 * 2;
constexpr size_t WS_KX   = WS_MEMB + (size_t)8192 * 1024 * 2;
constexpr size_t WS_VXT  = WS_KX + (size_t)2 * 8192 * 1024 * 2;
constexpr size_t WS_W    = WS_VXT + (size_t)2 * 8192 * 1024 * 2;
constexpr size_t W_GU1 = 0, W_D1 = W_GU1 + (size_t)5632 * 1024, W_IN = W_D1 + (size_t)1024 * 2816, W_OUT = W_IN + (size_t)4096 * 1024,
                 W_XQ = W_OUT + (size_t)1024 * 1024, W_XKV = W_XQ + (size_t)1024 * 1024, W_XO = W_XKV + (size_t)2048 * 1024,
                 W_GU2 = W_XO + (size_t)1024 * 1024, W_D2 = W_GU2 + (size_t)5632 * 1024, W_LAYER = W_D2 + (size_t)1024 * 2816;
constexpr size_t WS_ROWSS = WS_W + 2 * W_LAYER * 2;
constexpr size_t WS_MEMSS = WS_ROWSS + (size_t)9 * NTOK * 4;
constexpr size_t WS_CTR   = WS_MEMSS + (size_t)8192 * 4;
constexpr size_t WS_END   = WS_CTR + 256;

struct Params {
    const float *x, *mem, *ln_ffn1, *w1g, *w1u, *w1d, *ln_mix, *w_in, *lb_logits, *hgrn_gain, *w_out, *ln_xq, *ln_mem, *w_xq, *w_xkv, *w_xo, *ln_ffn2, *w2g, *w2u, *w2d, *ln_final;
    float* out; uchar* ws;
};

__device__ __forceinline__ unsigned cvt_pk_bf16(float lo, float hi) { unsigned r; asm volatile("v_cvt_pk_bf16_f32 %0, %1, %2" : "=v"(r) : "v"(lo), "v"(hi)); return r; }
__device__ __forceinline__ float bf2f(unsigned short b) { return __uint_as_float(((unsigned)b) << 16); }
__device__ __forceinline__ float bflo(unsigned u) { return __uint_as_float(u << 16); }
__device__ __forceinline__ float bfhi(unsigned u) { return __uint_as_float(u & 0xffff0000u); }
__device__ __forceinline__ float fast_rcp(float x) { return __builtin_amdgcn_rcpf(x); }
__device__ __forceinline__ float fast_exp(float x) { return __builtin_amdgcn_exp2f(x * 1.44269504089f); }
__device__ __forceinline__ float sigmoidf_(float x) { return fast_rcp(1.0f + fast_exp(-x)); }
__device__ __forceinline__ float siluf_(float x) { return x * sigmoidf_(x); }
__device__ __forceinline__ s16x4 tr_read(const LAS uchar* p) { typedef short v4i16_t __attribute__((ext_vector_type(4)));
    return __builtin_bit_cast(s16x4, __builtin_amdgcn_ds_read_tr16_b64_v4i16((LAS v4i16_t*)p)); }
__device__ __forceinline__ bf16x8 cat8(s16x4 lo, s16x4 hi) { bf16x8 r; r[0] = lo[0]; r[1] = lo[1]; r[2] = lo[2]; r[3] = lo[3]; r[4] = hi[0]; r[5] = hi[1]; r[6] = hi[2]; r[7] = hi[3]; return r; }
__device__ __forceinline__ bf16x8 pack8(f32x4 a, f32x4 b) { u32x4 w; w.x = cvt_pk_bf16(a[0], a[1]); w.y = cvt_pk_bf16(a[2], a[3]); w.z = cvt_pk_bf16(b[0], b[1]); w.w = cvt_pk_bf16(b[2], b[3]); return __builtin_bit_cast(bf16x8, w); }
__device__ __forceinline__ f32x4 mfma16(bf16x8 a, bf16x8 b, f32x4 c) { return __builtin_amdgcn_mfma_f32_16x16x32_bf16(a, b, c, 0, 0, 0); }

namespace pg8 {
constexpr int BM = 256, BK = 64, HALF = 128, HTB = HALF * BK * 2, STAGE_BYTES = 8 * HTB, NXCD = 8, WGM = 8;
__host__ __device__ __forceinline__ int lds_byte(int r, int c) { const int st = (r >> 4) * 2 + (c >> 5), rr = r & 15, cc = c & 31, ob = rr * 64 + cc * 2; return st * 1024 + (ob ^ (((ob >> 9) & 1) << 5)); }
__host__ __device__ __forceinline__ void stage_rc(int b, int& R, int& C) { const int st = b / 1024, sb = b % 1024, swz = sb ^ (((sb >> 9) & 1) << 5); R = (st >> 1) * 16 + swz / 64; C = (st & 1) * 32 + (swz % 64) / 2; }
__host__ __device__ __forceinline__ int perm32(int rho) { const int n = rho >> 4, i = rho & 15; return 8 * (i >> 2) + 4 * n + (i & 3); }
struct Unit { int pm, pn; };
struct Gemm { const bf16_t* A; const bf16_t* Bt; int M, N, K; };
struct StaticOrder {
    int nM, nN, nwg, G, c;
    __device__ void init(int M, int N, int G_, int c_) { nM = M / BM; nN = N / BM; nwg = nM * nN; G = G_; c = c_; }
    __device__ bool next(int i, Unit& u) const {
        const long L = (long)i * G + c; if (L >= nwg) return false;
        int wgid = (int)L; { const int q = nwg / NXCD, r = nwg % NXCD, xcd = wgid % NXCD, off = wgid / NXCD; wgid = (xcd < r ? xcd * (q + 1) : r * (q + 1) + (xcd - r) * q) + off; }
        const int nig = WGM * nN, gid = wgid / nig, fm = gid * WGM, gsz = (nM - fm) < WGM ? (nM - fm) : WGM;
        u.pm = fm + ((wgid % nig) % gsz); u.pn = (wgid % nig) / gsz; return true;
    }
};

template <class Epi>
__device__ __forceinline__ void gemm_phase(LAS uchar* lds, const Gemm g, const StaticOrder& S, const Epi& E) {
    int tid = threadIdx.x; asm volatile("" : "+v"(tid));
    const int wid = __builtin_amdgcn_readfirstlane(tid >> 6), lane = tid & 63, wr = wid >> 2, wc = wid & 3, fr = lane & 15, fq = lane >> 4;
    int K = g.K; const bf16_t* gA = g.A; const bf16_t* gBt = g.Bt;
    asm volatile("" : "+s"(K), "+s"(gA), "+s"(gBt));
    const int nt = K / BK;
    unsigned voffA[2], voffB[2];
#pragma unroll
    for (int i = 0; i < 2; ++i) { int R, C; stage_rc(tid * 16 + i * 8192, R, C); const int Rb = Epi::PERM ? ((R & ~31) + perm32(R & 31)) : R;
        voffA[i] = (unsigned)(R * K + C) * 2u; voffB[i] = (unsigned)(Rb * K + C) * 2u; }
    const size_t kstep = (size_t)(BK * 2);
    const size_t hstep = (size_t)HALF * K * 2;
    const size_t tstep = 2 * hstep;
    const unsigned ldsw = (unsigned)wid * 1024u;
    const int aoff = lds_byte(wr * 64 + fr, fq * 8), boff = lds_byte(wc * 32 + fr, fq * 8);
#define PG8_SA(b, h) (((b) * 2 + (h)) * HTB)
#define PG8_SB(b, h) ((4 + (b) * 2 + (h)) * HTB)
#define PG8_STAGE(bufoff, gbase, voff) do { _Pragma("unroll") for (int _i = 0; _i < 2; ++_i) \
        __builtin_amdgcn_global_load_lds((const unsigned*)((const char*)(gbase) + (voff)[_i]), (LAS unsigned*)(lds + (bufoff) + ldsw + _i * 8192), 16, 0, 0); } while (0)
#define PG8_LDA(dst, b, h) do { _Pragma("unroll") for (int m = 0; m < 4; ++m) _Pragma("unroll") for (int k = 0; k < 2; ++k) dst[m][k] = *(const LAS bf16x8*)(lds + PG8_SA(b, h) + aoff + m * 2048 + k * 1024); } while (0)
#define PG8_LDB(dst, b, h) do { _Pragma("unroll") for (int n = 0; n < 2; ++n) _Pragma("unroll") for (int k = 0; k < 2; ++k) dst[n][k] = *(const LAS bf16x8*)(lds + PG8_SB(b, h) + boff + n * 2048 + k * 1024); } while (0)
#define PG8_MMA(ai, bj, At, Bt) do { __builtin_amdgcn_s_setprio(1); _Pragma("unroll") for (int m = 0; m < 4; ++m) _Pragma("unroll") for (int n = 0; n < 2; ++n) _Pragma("unroll") for (int k = 0; k < 2; ++k) \
        acc[ai][bj][m][n] = __builtin_amdgcn_mfma_f32_16x16x32_bf16(Bt[n][k], At[m][k], acc[ai][bj][m][n], 0, 0, 0); __builtin_amdgcn_s_setprio(0); } while (0)
#define PG8_WAIT_V(n) asm volatile("s_waitcnt vmcnt(" #n ")" ::: "memory")
#define PG8_WAIT_L(n) asm volatile("s_waitcnt lgkmcnt(" #n ")" ::: "memory")
#define PG8_BAR __builtin_amdgcn_s_barrier()
#define PG8_SCHED __builtin_amdgcn_sched_barrier(0)
    Unit cur, nxt; int ui = 0;
    if (!S.next(0, cur)) return;
    f32x4 acc[2][2][4][2];
#pragma unroll
    for (int a = 0; a < 2; ++a)
#pragma unroll
        for (int b = 0; b < 2; ++b)
#pragma unroll
            for (int m = 0; m < 4; ++m)
#pragma unroll
                for (int n = 0; n < 2; ++n) acc[a][b][m][n] = (f32x4){0.f, 0.f, 0.f, 0.f};
    bf16x8 At[4][2], B0[2][2], B1[2][2];
    const char* cA = (const char*)gA + (size_t)cur.pm * tstep; const char* cB = (const char*)gBt + (size_t)cur.pn * tstep;
    PG8_STAGE(PG8_SB(0, 0), cB, voffB); PG8_STAGE(PG8_SA(0, 0), cA, voffA); PG8_STAGE(PG8_SB(0, 1), cB + hstep, voffB); PG8_STAGE(PG8_SA(0, 1), cA + hstep, voffA);
    if (wr == 1) PG8_BAR;
    PG8_WAIT_V(4); PG8_BAR;
    PG8_STAGE(PG8_SB(1, 0), cB + kstep, voffB); PG8_STAGE(PG8_SA(1, 0), cA + kstep, voffA); PG8_STAGE(PG8_SB(1, 1), cB + hstep + kstep, voffB);
    PG8_WAIT_V(6); PG8_BAR;
    for (;;) {
        const bool has_next = S.next(ui + 1, nxt);
        const char* nA = has_next ? (const char*)gA + (size_t)nxt.pm * tstep : cA; const char* nB = has_next ? (const char*)gBt + (size_t)nxt.pn * tstep : cB;
        for (int t = 0; t < nt; t += 2) {
            const bool last = (t == nt - 2);
            const char* a1 = cA + (size_t)(t + 1) * kstep;
            const char* a2 = last ? nA : cA + (size_t)(t + 2) * kstep; const char* b2 = last ? nB : cB + (size_t)(t + 2) * kstep;
            const char* a3 = a2 + kstep; const char* b3 = b2 + kstep;
            PG8_LDB(B0, 0, 0); PG8_SCHED; PG8_LDA(At, 0, 0); PG8_STAGE(PG8_SA(1, 1), a1 + hstep, voffA);
            PG8_WAIT_L(8); PG8_BAR; PG8_WAIT_L(0); PG8_MMA(0, 0, At, B0); PG8_BAR; PG8_SCHED;
            PG8_LDB(B1, 0, 1); PG8_STAGE(PG8_SB(0, 0), b2, voffB);
            PG8_BAR; PG8_WAIT_L(0); PG8_MMA(0, 1, At, B1); PG8_BAR;
            PG8_LDA(At, 0, 1); PG8_STAGE(PG8_SA(0, 0), a2, voffA);
            PG8_BAR; PG8_WAIT_L(0); PG8_MMA(1, 0, At, B0); PG8_BAR; PG8_SCHED;
            PG8_STAGE(PG8_SB(0, 1), b2 + hstep, voffB);
            PG8_WAIT_V(6); PG8_BAR; PG8_MMA(1, 1, At, B1); PG8_BAR;
            PG8_LDB(B0, 1, 0); PG8_SCHED; PG8_LDA(At, 1, 0); PG8_STAGE(PG8_SA(0, 1), a2 + hstep, voffA);
            PG8_WAIT_L(8); PG8_BAR; PG8_WAIT_L(0); PG8_MMA(0, 0, At, B0); PG8_BAR; PG8_SCHED;
            PG8_LDB(B1, 1, 1); PG8_STAGE(PG8_SB(1, 0), b3, voffB);
            PG8_BAR; PG8_WAIT_L(0); PG8_MMA(0, 1, At, B1); PG8_BAR;
            PG8_LDA(At, 1, 1); PG8_STAGE(PG8_SA(1, 0), a3, voffA);
            PG8_BAR; PG8_WAIT_L(0); PG8_MMA(1, 0, At, B0); PG8_BAR; PG8_SCHED;
            PG8_STAGE(PG8_SB(1, 1), b3 + hstep, voffB);
            PG8_WAIT_V(6); PG8_BAR; PG8_MMA(1, 1, At, B1); PG8_BAR;
        }
        E(acc, cur, wr, wc, fr, fq);
        if (!has_next) break;
#pragma unroll
        for (int a = 0; a < 2; ++a)
#pragma unroll
            for (int b = 0; b < 2; ++b)
#pragma unroll
                for (int m = 0; m < 4; ++m)
#pragma unroll
                    for (int n = 0; n < 2; ++n) acc[a][b][m][n] = (f32x4){0.f, 0.f, 0.f, 0.f};
        cur = nxt; cA = nA; cB = nB; ++ui;
    }
    PG8_WAIT_V(0);
    if (wr == 0) PG8_BAR;
    PG8_BAR;
#undef PG8_SA
#undef PG8_SB
#undef PG8_STAGE
#undef PG8_LDA
#undef PG8_LDB
#undef PG8_MMA
#undef PG8_WAIT_V
#undef PG8_WAIT_L
#undef PG8_BAR
#undef PG8_SCHED
}

__device__ __forceinline__ float row_rstd(const float* ss, int row) { return __builtin_amdgcn_rsqf(ss[row] * (1.0f / 1024.0f) + EPS); }

struct EpiSwiglu {
    static constexpr bool PERM = true;
    bf16_t* O; const float* rowss;
    __device__ __forceinline__ void operator()(const f32x4 (&acc)[2][2][4][2], const Unit& u, int wr, int wc, int fr, int fq) const {
        const int row0 = u.pm * BM + wr * 64 + fr, col0 = u.pn * 128 + wc * 32 + 8 * fq;
#pragma unroll
        for (int ai = 0; ai < 2; ++ai)
#pragma unroll
            for (int m = 0; m < 4; ++m) { const int row = row0 + ai * HALF + m * 16; const float rs = row_rstd(rowss, row);
                f32x4 o0, o1;
#pragma unroll
                for (int j = 0; j < 4; ++j) { o0[j] = siluf_(acc[ai][0][m][0][j] * rs) * (acc[ai][1][m][0][j] * rs); o1[j] = siluf_(acc[ai][0][m][1][j] * rs) * (acc[ai][1][m][1][j] * rs); }
                *(bf16x8*)(O + (size_t)row * D_FF + col0) = pack8(o0, o1); }
    }
};
struct EpiRes {
    static constexpr bool PERM = true;
    const float* res; float* out; bf16_t* hb; float* rowss_next; float scale;
    __device__ __forceinline__ void operator()(const f32x4 (&acc)[2][2][4][2], const Unit& u, int wr, int wc, int fr, int fq) const {
        const int row0 = u.pm * BM + wr * 64 + fr, col0 = u.pn * BM + wc * 32 + 8 * fq;
#pragma unroll
        for (int ai = 0; ai < 2; ++ai)
#pragma unroll
            for (int m = 0; m < 4; ++m) { const int row = row0 + ai * HALF + m * 16; float ss = 0.f;
#pragma unroll
                for (int bj = 0; bj < 2; ++bj) { const size_t idx = (size_t)row * D_MODEL + col0 + bj * HALF;
                    const f32x4 r0 = *(const f32x4*)(res + idx), r1 = *(const f32x4*)(res + idx + 4);
                    const f32x4 h0 = r0 + acc[ai][bj][m][0] * scale, h1 = r1 + acc[ai][bj][m][1] * scale;
                    *(f32x4*)(out + idx) = h0; *(f32x4*)(out + idx + 4) = h1;
                    *(bf16x8*)(hb + idx) = pack8(h0, h1);
#pragma unroll
                    for (int j = 0; j < 4; ++j) ss += h0[j] * h0[j] + h1[j] * h1[j]; }
                ss += __shfl_xor(ss, 16); ss += __shfl_xor(ss, 32);
                if (fq == 0) atomicAdd(rowss_next + row, ss); }
    }
};
struct EpiScale {
    static constexpr bool PERM = true;
    bf16_t* O; int ldo; const float* rowss; float cs;
    __device__ __forceinline__ void operator()(const f32x4 (&acc)[2][2][4][2], const Unit& u, int wr, int wc, int fr, int fq) const {
        const int row0 = u.pm * BM + wr * 64 + fr, col0 = u.pn * BM + wc * 32 + 8 * fq;
#pragma unroll
        for (int ai = 0; ai < 2; ++ai)
#pragma unroll
            for (int m = 0; m < 4; ++m) { const int row = row0 + ai * HALF + m * 16; const float rs = row_rstd(rowss, row) * cs;
#pragma unroll
                for (int bj = 0; bj < 2; ++bj) *(bf16x8*)(O + (size_t)row * ldo + col0 + bj * HALF) = pack8(acc[ai][bj][m][0] * rs, acc[ai][bj][m][1] * rs); }
    }
};
struct EpiMemKV {
    static constexpr bool PERM = true;
    bf16_t* KX; bf16_t* VXT; const float* rowss;
    __device__ __forceinline__ void operator()(const f32x4 (&acc)[2][2][4][2], const Unit& u, int wr, int wc, int fr, int fq) const {
        const int row0 = u.pm * BM + wr * 64 + fr, col0 = u.pn * BM + wc * 32 + 8 * fq;
#pragma unroll
        for (int ai = 0; ai < 2; ++ai)
#pragma unroll
            for (int m = 0; m < 4; ++m) { const int row = row0 + ai * HALF + m * 16; const float rs = row_rstd(rowss, row);
#pragma unroll
                for (int bj = 0; bj < 2; ++bj) { const int col = col0 + bj * HALF;
                    if (u.pn < 4) { *(bf16x8*)(KX + (size_t)row * 1024 + col) = pack8(acc[ai][bj][m][0] * rs, acc[ai][bj][m][1] * rs); }
                    else { const int jrow = row & 255; bf16_t* vp = VXT + ((size_t)u.pm * 1024 + (col - 1024)) * 256 + jrow;
#pragma unroll
                        for (int n = 0; n < 2; ++n)
#pragma unroll
                            for (int j = 0; j < 4; ++j) vp[(size_t)(4 * n + j) * 256] = (bf16_t)(cvt_pk_bf16(acc[ai][bj][m][n][j] * rs, 0.f) & 0xffffu); } } }
    }
};
}

__device__ __forceinline__ void convert_tile(LAS uchar* lds, const float* W, int K, int N, bf16_t* dst, int rs, int off, const float* gain, int tile) {
    const int tid = threadIdx.x; LAS float* T = (LAS float*)lds;
    const int ntn = N >> 6, tk = tile / ntn, tn = tile - tk * ntn, k0 = tk * 64, n0 = tn * 64;
    { const int kk = tid >> 3, c8 = (tid & 7) * 8; const float* src = W + (size_t)(k0 + kk) * N + n0 + c8;
      const f32x4 a = *(const f32x4*)src, b = *(const f32x4*)(src + 4); const float gk = gain ? gain[k0 + kk] : 1.0f;
#pragma unroll
      for (int j = 0; j < 4; ++j) { T[kk * 65 + c8 + j] = a[j] * gk; T[kk * 65 + c8 + 4 + j] = b[j] * gk; } }
    __syncthreads();
    { const int n = tid >> 3, k8 = (tid & 7) * 8; f32x4 a, b;
#pragma unroll
      for (int j = 0; j < 4; ++j) { a[j] = T[(k8 + j) * 65 + n]; b[j] = T[(k8 + 4 + j) * 65 + n]; }
      const int nn = n0 + n, drow = (nn >> 7) * rs + (nn & 127) + off;
      *(bf16x8*)(dst + (size_t)drow * K + k0 + k8) = pack8(a, b); }
    __syncthreads();
}
__device__ __forceinline__ void convert_weight(LAS uchar* lds, const float* W, int K, int N, bf16_t* dst, int rs, int off, const float* gain, int& base) {
    const int G = gridDim.x, nt = (K >> 6) * (N >> 6);
    for (int t = (int)((blockIdx.x + G - (base % G)) % G); t < nt; t += G) convert_tile(lds, W, K, N, dst, rs, off, gain, t);
    base += nt;
}
__device__ __forceinline__ void convert_rows(const float* X, bf16_t* Xb, float* ss, int nrows) {
    const int lane = threadIdx.x & 63, gw = blockIdx.x * 8 + (threadIdx.x >> 6), nw = gridDim.x * 8;
    for (int r = gw; r < nrows; r += nw) { const float* src = X + (size_t)r * 1024; bf16_t* dp = Xb + (size_t)r * 1024; float s = 0.f;
#pragma unroll
        for (int i = 0; i < 4; ++i) { const f32x4 v = *(const f32x4*)(src + i * 256 + lane * 4); s += v[0] * v[0] + v[1] * v[1] + v[2] * v[2] + v[3] * v[3];
            u32x2 w; w.x = cvt_pk_bf16(v[0], v[1]); w.y = cvt_pk_bf16(v[2], v[3]); *(u32x2*)(dp + i * 256 + lane * 4) = w; }
#pragma unroll
        for (int o = 32; o >= 1; o >>= 1) s += __shfl_xor(s, o);
        if (lane == 0) ss[r] = s; }
}
__device__ __forceinline__ void final_norm(float* out, const float* ss, const float* gain) {
    const int lane = threadIdx.x & 63, gw = blockIdx.x * 8 + (threadIdx.x >> 6), nw = gridDim.x * 8;
    f32x4 gv[4];
#pragma unroll
    for (int i = 0; i < 4; ++i) gv[i] = *(const f32x4*)(gain + i * 256 + lane * 4);
    for (int r = gw; r < NTOK; r += nw) { float* p = out + (size_t)r * 1024; const float rs = pg8::row_rstd(ss, r);
#pragma unroll
        for (int i = 0; i < 4; ++i) { f32x4 v = *(const f32x4*)(p + i * 256 + lane * 4); v = v * rs * gv[i]; *(f32x4*)(p + i * 256 + lane * 4) = v; } }
}

constexpr int HG_ROW = 272, HG_PROW = 144;
constexpr int HG_QD = 0, HG_KD = 64 * HG_ROW, HG_VV = 2 * 64 * HG_ROW, HG_PP = 3 * 64 * HG_ROW, HG_SREF = HG_PP + 64 * HG_PROW, HG_SE2 = HG_SREF + 512, HG_RED = HG_SE2 + 512, HG_DIR_BYTES = HG_RED + 1024;
static_assert(2 * HG_DIR_BYTES <= LDS_BYTES - 64, "hgrn lds");

__device__ void hgrn_unit(LAS uchar* lds_all, const Params& p, int layer, int unit) {
    int tid = threadIdx.x; asm volatile("" : "+v"(tid));
    const int lane = tid & 63, wid = __builtin_amdgcn_readfirstlane(tid >> 6), dir = wid >> 2, w = wid & 3, dtid = tid & 255;
    const int fr = lane & 15, g = lane >> 4, q_ = fr >> 2, p_ = fr & 3;
    const int b = unit >> 2, hd = unit & 3;
    LAS uchar* L = lds_all + dir * HG_DIR_BYTES;
    const bf16_t* proj = (const bf16_t*)(p.ws + WS_BIG) + (size_t)b * SEQ * IN_COLS;
    float* tmp = (float*)(p.ws + WS_HB) + (size_t)b * SEQ * 512;
    bf16_t* Y = (bf16_t*)(p.ws + WS_Y) + (size_t)b * SEQ * 1024;
    const int pk = dtid & 127, half = __builtin_amdgcn_readfirstlane(dtid >> 7);
    float lb = 0.f;
    if (layer == 1) { const float l0 = p.lb_logits[(0 * 2 + dir) * 512 + hd * 128 + pk], l1 = p.lb_logits[(1 * 2 + dir) * 512 + hd * 128 + pk]; lb = sigmoidf_(l1 - l0); }
    const float omlb = 1.0f - lb;
    const int zcol = 1024 + dir * 512 + hd * 128 + pk, qcol = hd * 128 + pk;

    f32x4 sacc[8][2];
#pragma unroll
    for (int kt = 0; kt < 8; ++kt) { sacc[kt][0] = (f32x4){0.f, 0.f, 0.f, 0.f}; sacc[kt][1] = (f32x4){0.f, 0.f, 0.f, 0.f}; }

    for (int step = 0; step < 32; ++step) {
        const int tok0 = (dir == 0 ? step : 31 - step) * 64;
        {
            { const int rowi = dtid >> 2, seg = dtid & 3, tau = dir == 0 ? rowi : 63 - rowi; const unsigned so = (unsigned)((tok0 + rowi) * IN_COLS + 512 + hd * 128 + seg * 32) * 2u;
#pragma unroll
              for (int i = 0; i < 4; ++i) *(LAS u32x4*)(L + HG_VV + tau * HG_ROW + seg * 64 + i * 16) = *(const u32x4*)((const char*)proj + so + i * 16); }
            float E = 1.0f;
#pragma unroll
            for (int hb = 0; hb < 2; ++hb) {
                unsigned short zr[16], qr[16];
#pragma unroll
                for (int i2 = 0; i2 < 16; ++i2) { const int i = hb * 16 + i2; const int tau = half ? 32 + i : 31 - i; const int tl = dir == 0 ? tau : 63 - tau; const unsigned ro = (unsigned)((tok0 + tl) * IN_COLS) * 2u;
                    zr[i2] = *(const bf16_t*)((const char*)proj + ro + zcol * 2); qr[i2] = *(const bf16_t*)((const char*)proj + ro + qcol * 2); }
#pragma unroll
                for (int i2 = 0; i2 < 16; ++i2) { const int i = hb * 16 + i2; const int tau = half ? 32 + i : 31 - i;
                    const float z = bf2f(zr[i2]), q = bf2f(qr[i2]); const float s = sigmoidf_(z), f = lb + omlb * s, kk = omlb * (1.0f - s);
                    float qd, kd;
                    if (half) { E = fmaxf(E * f, 1e-30f); qd = q * E; kd = kk * fast_rcp(E); }
                    else { qd = q * fast_rcp(E); kd = kk * E; E = fmaxf(E * f, 1e-30f); }
                    *(LAS bf16_t*)(L + HG_QD + tau * HG_ROW + pk * 2) = (bf16_t)(cvt_pk_bf16(qd, 0.f) & 0xffffu);
                    *(LAS bf16_t*)(L + HG_KD + tau * HG_ROW + pk * 2) = (bf16_t)(cvt_pk_bf16(kd, 0.f) & 0xffffu); }
            }
            *(LAS float*)(L + (half ? HG_SE2 : HG_SREF) + pk * 4) = E;
        }
        __syncthreads();
#pragma unroll
        for (int st = 0; st < 4; ++st) { f32x4 a = (f32x4){0.f, 0.f, 0.f, 0.f};
            if (st <= w) {
#pragma unroll
                for (int ks = 0; ks < 4; ++ks) { const bf16x8 ka = *(const LAS bf16x8*)(L + HG_KD + (16 * st + fr) * HG_ROW + (32 * ks + 8 * g) * 2);
                    const bf16x8 qb = *(const LAS bf16x8*)(L + HG_QD + (16 * w + fr) * HG_ROW + (32 * ks + 8 * g) * 2); a = mfma16(ka, qb, a); }
#pragma unroll
                for (int r = 0; r < 4; ++r) if (16 * st + 4 * g + r > 16 * w + fr) a[r] = 0.f; }
            u32x2 pw; pw.x = cvt_pk_bf16(a[0], a[1]); pw.y = cvt_pk_bf16(a[2], a[3]);
            *(LAS u32x2*)(L + HG_PP + (16 * w + fr) * HG_PROW + (16 * st + 4 * g) * 2) = pw; }
#pragma unroll
        for (int kt = 0; kt < 8; ++kt) { const f32x4 sr = *(const LAS f32x4*)(L + HG_SREF + (16 * kt + 4 * g) * 4); sacc[kt][0] *= sr; sacc[kt][1] *= sr; }
        bf16x8 vf[2][2];
#pragma unroll
        for (int vt = 0; vt < 2; ++vt)
#pragma unroll
            for (int ks = 0; ks < 2; ++ks) { const LAS uchar* a = L + HG_VV + (32 * ks + 8 * g + q_) * HG_ROW + (32 * w + 16 * vt + 4 * p_) * 2; vf[vt][ks] = cat8(tr_read(a), tr_read(a + 4 * HG_ROW)); }
        __syncthreads();
        f32x4 oacc[2][4];
#pragma unroll
        for (int vt = 0; vt < 2; ++vt)
#pragma unroll
            for (int tt = 0; tt < 4; ++tt) oacc[vt][tt] = (f32x4){0.f, 0.f, 0.f, 0.f};
#pragma unroll
        for (int tt = 0; tt < 4; ++tt)
#pragma unroll
            for (int ks = 0; ks < 2; ++ks) { const bf16x8 pb = *(const LAS bf16x8*)(L + HG_PP + (16 * tt + fr) * HG_PROW + (32 * ks + 8 * g) * 2);
                oacc[0][tt] = mfma16(vf[0][ks], pb, oacc[0][tt]); oacc[1][tt] = mfma16(vf[1][ks], pb, oacc[1][tt]); }
#pragma unroll
        for (int ks = 0; ks < 4; ++ks) { const bf16x8 sa0 = pack8(sacc[2 * ks][0], sacc[2 * ks + 1][0]), sa1 = pack8(sacc[2 * ks][1], sacc[2 * ks + 1][1]);
#pragma unroll
            for (int tt = 0; tt < 4; ++tt) { const LAS uchar* qa = L + HG_QD + (16 * tt + fr) * HG_ROW + (32 * ks + 4 * g) * 2;
                const u32x2 lo = *(const LAS u32x2*)qa, hi = *(const LAS u32x2*)(qa + 32); u32x4 qq; qq.x = lo.x; qq.y = lo.y; qq.z = hi.x; qq.w = hi.y;
                const bf16x8 qb = __builtin_bit_cast(bf16x8, qq);
                oacc[0][tt] = mfma16(sa0, qb, oacc[0][tt]); oacc[1][tt] = mfma16(sa1, qb, oacc[1][tt]); } }
#pragma unroll
        for (int kt = 0; kt < 8; ++kt) {
#pragma unroll
            for (int ks = 0; ks < 2; ++ks) { const LAS uchar* a = L + HG_KD + (32 * ks + 8 * g + q_) * HG_ROW + (16 * kt + 4 * p_) * 2; const bf16x8 ka = cat8(tr_read(a), tr_read(a + 4 * HG_ROW));
                sacc[kt][0] = mfma16(ka, vf[0][ks], sacc[kt][0]); sacc[kt][1] = mfma16(ka, vf[1][ks], sacc[kt][1]); }
            const f32x4 e2 = *(const LAS f32x4*)(L + HG_SE2 + (16 * kt + 4 * g) * 4); sacc[kt][0] *= e2; sacc[kt][1] *= e2; }
        const bool second = step >= 16;
        float ssq[4];
#pragma unroll
        for (int tt = 0; tt < 4; ++tt) { const int tau = 16 * tt + fr, tl = dir == 0 ? tau : 63 - tau; float s = 0.f;
#pragma unroll
            for (int vt = 0; vt < 2; ++vt) { float* tp = tmp + (size_t)(tok0 + tl) * 512 + hd * 128 + 32 * w + 16 * vt + 4 * g;
                if (!second) *(f32x4*)tp = oacc[vt][tt];
                else { oacc[vt][tt] += *(const f32x4*)tp; const f32x4 o = oacc[vt][tt]; s += o[0] * o[0] + o[1] * o[1] + o[2] * o[2] + o[3] * o[3]; } }
            ssq[tt] = s; }
        if (second) {
#pragma unroll
            for (int tt = 0; tt < 4; ++tt) { float s = ssq[tt]; s += __shfl_xor(s, 16); s += __shfl_xor(s, 32); if (g == 0) *(LAS float*)(L + HG_RED + (w * 64 + 16 * tt + fr) * 4) = s; } }
        __syncthreads();
        if (second) {
#pragma unroll
            for (int tt = 0; tt < 4; ++tt) { const int tau = 16 * tt + fr, tl = dir == 0 ? tau : 63 - tau;
                const float tot = *(const LAS float*)(L + HG_RED + tau * 4) + *(const LAS float*)(L + HG_RED + (64 + tau) * 4) + *(const LAS float*)(L + HG_RED + (128 + tau) * 4) + *(const LAS float*)(L + HG_RED + (192 + tau) * 4);
                const float rs = __builtin_amdgcn_rsqf(tot * (1.0f / 128.0f) + EPS);
#pragma unroll
                for (int vt = 0; vt < 2; ++vt) { const int v = hd * 128 + 32 * w + 16 * vt + 4 * g;
                    const f32x4 gn = *(const f32x4*)(p.hgrn_gain + layer * 512 + v);
                    const u32x2 gt = *(const u32x2*)(proj + (size_t)(tok0 + tl) * IN_COLS + 2048 + v);
                    const f32x4 o = oacc[vt][tt] * rs * gn;
                    u32x2 yw; yw.x = cvt_pk_bf16(o[0] * siluf_(bflo(gt.x)), o[1] * siluf_(bfhi(gt.x))); yw.y = cvt_pk_bf16(o[2] * siluf_(bflo(gt.y)), o[3] * siluf_(bfhi(gt.y)));
                    *(u32x2*)(Y + (size_t)(tok0 + tl) * 1024 + v) = yw; } } }
    }
    __syncthreads();
}

constexpr int DA_OROW = 136, DA_OB = 0, DA_LSE = 3 * 256 * DA_OROW, DA_STG = DA_LSE + 3 * 256 * 4, DA_SROW = 144, DA_STG_W = 32 * DA_SROW;
static_assert(DA_STG + 8 * DA_STG_W <= LDS_BYTES - 64, "dattn lds");

__device__ void dattn_unit(LAS uchar* lds, const Params& p, int unit) {
    int tid = threadIdx.x; asm volatile("" : "+v"(tid));
    const int lane = tid & 63, wid = __builtin_amdgcn_readfirstlane(tid >> 6);
    const int fr = lane & 15, g = lane >> 4, q_ = fr >> 2, p_ = fr & 3;
    const int b = unit >> 6, head = (unit >> 3) & 7, qb = unit & 7, t0 = qb * 256;
    const bf16_t* proj = (const bf16_t*)(p.ws + WS_BIG) + (size_t)b * SEQ * IN_COLS;
    bf16_t* Y = (bf16_t*)(p.ws + WS_Y) + (size_t)b * SEQ * 1024;
    LAS uchar* STG = lds + DA_STG + wid * DA_STG_W;
    const float slope = __builtin_amdgcn_exp2f(-(float)(head + 1));
    const float NEG_INF = -__builtin_inff();

#pragma unroll 1
    for (int task = 0; task < 6; ++task) {
        const int br = task >> 1, j = 2 * wid + (task & 1), sh = 2 * br, d = 1 << sh, r = j & (d - 1), jj = j >> sh;
        const int mq0 = (t0 >> sh) + 16 * jj, Ls = SEQ >> sh;
        const float sd = slope * (float)d;
        bf16x8 qf[2];
        { const unsigned qo = (unsigned)((((mq0 + fr) << sh) + r) * IN_COLS + 2560 + head * 64 + 8 * g) * 2u; qf[0] = *(const bf16x8*)((const char*)proj + qo); qf[1] = *(const bf16x8*)((const char*)proj + qo + 64); }
        f32x4 sc[9];
#pragma unroll
        for (int it = 0; it < 9; ++it) { const int mk0 = mq0 - 64 + 16 * it; const bool valid = (mk0 >= 0) && (mk0 < Ls);
            const int mkc = mk0 < 0 ? 0 : (mk0 > Ls - 16 ? Ls - 16 : mk0);
            const unsigned ko = (unsigned)((((mkc + fr) << sh) + r) * IN_COLS + 3072 + head * 64 + 8 * g) * 2u;
            const bf16x8 k0 = *(const bf16x8*)((const char*)proj + ko), k1 = *(const bf16x8*)((const char*)proj + ko + 64);
            f32x4 a = (f32x4){0.f, 0.f, 0.f, 0.f}; a = mfma16(k0, qf[0], a); a = mfma16(k1, qf[1], a);
#pragma unroll
            for (int rg = 0; rg < 4; ++rg) { const int rel = 16 * it + 4 * g + rg - 64 - fr, ar = rel < 0 ? -rel : rel; const float s = a[rg] * 0.125f - sd * (float)ar; a[rg] = (valid && ar <= 64) ? s : NEG_INF; }
            sc[it] = a; }
        float mx = NEG_INF;
#pragma unroll
        for (int it = 0; it < 9; ++it) mx = fmaxf(fmaxf(fmaxf(sc[it][0], sc[it][1]), fmaxf(sc[it][2], sc[it][3])), mx);
        mx = fmaxf(mx, __shfl_xor(mx, 16)); mx = fmaxf(mx, __shfl_xor(mx, 32));
        float ls = 0.f;
#pragma unroll
        for (int it = 0; it < 9; ++it)
#pragma unroll
            for (int rg = 0; rg < 4; ++rg) { const float e = fast_exp(sc[it][rg] - mx); sc[it][rg] = e; ls += e; }
        ls += __shfl_xor(ls, 16); ls += __shfl_xor(ls, 32);
        f32x4 oacc[4];
#pragma unroll
        for (int dt = 0; dt < 4; ++dt) oacc[dt] = (f32x4){0.f, 0.f, 0.f, 0.f};
#pragma unroll
        for (int pi = 0; pi < 5; ++pi) {
            const bf16x8 pb = pack8(sc[2 * pi], pi < 4 ? sc[2 * pi + 1] : (f32x4){0.f, 0.f, 0.f, 0.f});
            { const int row = lane >> 1; int tile = 2 * pi + (row >> 4); if (tile > 8) tile = 8;
              const int mk0 = mq0 - 64 + 16 * tile, mkc = mk0 < 0 ? 0 : (mk0 > Ls - 16 ? Ls - 16 : mk0);
              const unsigned vo = (unsigned)((((mkc + (row & 15)) << sh) + r) * IN_COLS + 3584 + head * 64 + (lane & 1) * 32) * 2u;
#pragma unroll
              for (int i = 0; i < 4; ++i) *(LAS u32x4*)(STG + row * DA_SROW + (lane & 1) * 64 + i * 16) = *(const u32x4*)((const char*)proj + vo + i * 16); }
#pragma unroll
            for (int dt = 0; dt < 4; ++dt) { const LAS uchar* a = STG + (4 * g + q_) * DA_SROW + (16 * dt + 4 * p_) * 2; const bf16x8 vf = cat8(tr_read(a), tr_read(a + 16 * DA_SROW)); oacc[dt] = mfma16(vf, pb, oacc[dt]); }
        }
        const float inv = fast_rcp(ls);
        const int tl = ((16 * jj + fr) << sh) + r;
#pragma unroll
        for (int dt = 0; dt < 4; ++dt) { u32x2 w2; w2.x = cvt_pk_bf16(oacc[dt][0] * inv, oacc[dt][1] * inv); w2.y = cvt_pk_bf16(oacc[dt][2] * inv, oacc[dt][3] * inv);
            *(LAS u32x2*)(lds + DA_OB + (br * 256 + tl) * DA_OROW + (16 * dt + 4 * g) * 2) = w2; }
        if (g == 0) *(LAS float*)(lds + DA_LSE + (br * 256 + tl) * 4) = mx + __logf(ls);
    }
    __syncthreads();
    { const int tl = tid >> 1, hf = tid & 1;
      const float l0 = *(const LAS float*)(lds + DA_LSE + tl * 4), l1 = *(const LAS float*)(lds + DA_LSE + (256 + tl) * 4), l2 = *(const LAS float*)(lds + DA_LSE + (512 + tl) * 4);
      const float M = fmaxf(l0, fmaxf(l1, l2)); float w0 = fast_exp(l0 - M), w1 = fast_exp(l1 - M), w2 = fast_exp(l2 - M); const float inv = fast_rcp(w0 + w1 + w2); w0 *= inv; w1 *= inv; w2 *= inv;
      bf16_t* yp = Y + (size_t)(t0 + tl) * 1024 + 512 + head * 64 + hf * 32;
#pragma unroll
      for (int c = 0; c < 4; ++c) { f32x4 o[2];
#pragma unroll
          for (int h2 = 0; h2 < 2; ++h2) { const int off = (hf * 32 + 8 * c + 4 * h2) * 2;
              const u32x2 a0 = *(const LAS u32x2*)(lds + DA_OB + tl * DA_OROW + off), a1 = *(const LAS u32x2*)(lds + DA_OB + (256 + tl) * DA_OROW + off), a2 = *(const LAS u32x2*)(lds + DA_OB + (512 + tl) * DA_OROW + off);
              o[h2][0] = w0 * bflo(a0.x) + w1 * bflo(a1.x) + w2 * bflo(a2.x); o[h2][1] = w0 * bfhi(a0.x) + w1 * bfhi(a1.x) + w2 * bfhi(a2.x);
              o[h2][2] = w0 * bflo(a0.y) + w1 * bflo(a1.y) + w2 * bflo(a2.y); o[h2][3] = w0 * bfhi(a0.y) + w1 * bfhi(a1.y) + w2 * bfhi(a2.y); }
          *(bf16x8*)(yp + 8 * c) = pack8(o[0], o[1]); } }
    __syncthreads();
}

__device__ void xattn_unit(const Params& p, int layer, int unit) {
    int tid = threadIdx.x; asm volatile("" : "+v"(tid));
    const int lane = tid & 63, wid = __builtin_amdgcn_readfirstlane(tid >> 6);
    const int fr = lane & 15, g = lane >> 4;
    const int b = unit >> 5, hx = (unit >> 3) & 3, qb = unit & 7;
    const bf16_t* qx = (const bf16_t*)(p.ws + WS_BIG) + ((size_t)b * SEQ + qb * 256 + wid * 32) * 1024 + hx * 256;
    const bf16_t* KX = (const bf16_t*)(p.ws + WS_KX) + ((size_t)layer * 8192 + (size_t)b * 256) * 1024 + hx * 256;
    const bf16_t* VT = (const bf16_t*)(p.ws + WS_VXT) + ((size_t)layer * 32 + b) * 1024 * 256 + (size_t)hx * 256 * 256;
    bf16_t* OX = (bf16_t*)(p.ws + WS_Y) + ((size_t)b * SEQ + qb * 256 + wid * 32) * 1024 + hx * 256;
    f32x4 acc[2][16];
#pragma unroll
    for (int qt = 0; qt < 2; ++qt)
#pragma unroll
        for (int kt = 0; kt < 16; ++kt) acc[qt][kt] = (f32x4){0.f, 0.f, 0.f, 0.f};
    {
        bf16x8 qf[2][8];
#pragma unroll
        for (int qt = 0; qt < 2; ++qt)
#pragma unroll
            for (int ks = 0; ks < 8; ++ks) qf[qt][ks] = *(const bf16x8*)((const char*)qx + (unsigned)((16 * qt + fr) * 1024 + 32 * ks + 8 * g) * 2u);
#pragma unroll
        for (int kt = 0; kt < 16; ++kt) {
#pragma unroll
            for (int kh = 0; kh < 2; ++kh) { bf16x8 kf[4];
#pragma unroll
                for (int ks = 0; ks < 4; ++ks) kf[ks] = *(const bf16x8*)((const char*)KX + (unsigned)((16 * kt + fr) * 1024 + 32 * (4 * kh + ks) + 8 * g) * 2u);
#pragma unroll
                for (int ks = 0; ks < 4; ++ks) { acc[0][kt] = mfma16(kf[ks], qf[0][4 * kh + ks], acc[0][kt]); acc[1][kt] = mfma16(kf[ks], qf[1][4 * kh + ks], acc[1][kt]); } }
        }
    }
    float inv[2];
    bf16x8 pk[2][8];
#pragma unroll
    for (int qt = 0; qt < 2; ++qt) { float mx = -__builtin_inff();
#pragma unroll
        for (int kt = 0; kt < 16; ++kt) mx = fmaxf(fmaxf(fmaxf(acc[qt][kt][0], acc[qt][kt][1]), fmaxf(acc[qt][kt][2], acc[qt][kt][3])), mx);
        mx = fmaxf(mx, __shfl_xor(mx, 16)); mx = fmaxf(mx, __shfl_xor(mx, 32));
        float ls = 0.f;
#pragma unroll
        for (int kt = 0; kt < 16; ++kt)
#pragma unroll
            for (int rg = 0; rg < 4; ++rg) { const float e = fast_exp(acc[qt][kt][rg] - mx); acc[qt][kt][rg] = e; ls += e; }
        ls += __shfl_xor(ls, 16); ls += __shfl_xor(ls, 32); inv[qt] = fast_rcp(ls);
#pragma unroll
        for (int ks = 0; ks < 8; ++ks) pk[qt][ks] = pack8(acc[qt][2 * ks], acc[qt][2 * ks + 1]); }
#pragma unroll
    for (int dt = 0; dt < 16; ++dt) { f32x4 o0 = (f32x4){0.f, 0.f, 0.f, 0.f}, o1 = (f32x4){0.f, 0.f, 0.f, 0.f};
        const unsigned vo = (unsigned)((16 * dt + fr) * 256 + 4 * g) * 2u;
#pragma unroll
        for (int ks = 0; ks < 8; ++ks) { const u32x2 lo = *(const u32x2*)((const char*)VT + vo + 64 * ks), hi = *(const u32x2*)((const char*)VT + vo + 64 * ks + 32); u32x4 vv; vv.x = lo.x; vv.y = lo.y; vv.z = hi.x; vv.w = hi.y;
            const bf16x8 vf = __builtin_bit_cast(bf16x8, vv); o0 = mfma16(vf, pk[0][ks], o0); o1 = mfma16(vf, pk[1][ks], o1); }
        u32x2 w0; w0.x = cvt_pk_bf16(o0[0] * inv[0], o0[1] * inv[0]); w0.y = cvt_pk_bf16(o0[2] * inv[0], o0[3] * inv[0]);
        u32x2 w1; w1.x = cvt_pk_bf16(o1[0] * inv[1], o1[1] * inv[1]); w1.y = cvt_pk_bf16(o1[2] * inv[1], o1[3] * inv[1]);
        *(u32x2*)(OX + (size_t)fr * 1024 + 16 * dt + 4 * g) = w0; *(u32x2*)(OX + (size_t)(16 + fr) * 1024 + 16 * dt + 4 * g) = w1; }
}

__global__ void __launch_bounds__(512) fwd_megakernel(Params p) {
    extern __shared__ __attribute__((aligned(16))) uchar lds_raw[];
    LAS uchar* lds = (LAS uchar*)lds_raw;
    cg::grid_group grid = cg::this_grid();
    const int tid = threadIdx.x, G = gridDim.x;
    uchar* ws = p.ws;
    bf16_t* HB = (bf16_t*)(ws + WS_HB); bf16_t* BIG = (bf16_t*)(ws + WS_BIG); bf16_t* YB = (bf16_t*)(ws + WS_Y); bf16_t* MEMB = (bf16_t*)(ws + WS_MEMB);
    bf16_t* WB = (bf16_t*)(ws + WS_W); float* ROWSS = (float*)(ws + WS_ROWSS); float* MEMSS = (float*)(ws + WS_MEMSS); unsigned* CTR = (unsigned*)(ws + WS_CTR);

    {
        int base = 0;
        for (int l = 0; l < 2; ++l) { bf16_t* W = WB + (size_t)l * W_LAYER;
            convert_weight(lds, p.w1g + (size_t)l * 1024 * 2816, 1024, 2816, W + W_GU1, 256, 0, p.ln_ffn1 + l * 1024, base);
            convert_weight(lds, p.w1u + (size_t)l * 1024 * 2816, 1024, 2816, W + W_GU1, 256, 128, p.ln_ffn1 + l * 1024, base);
            convert_weight(lds, p.w1d + (size_t)l * 2816 * 1024, 2816, 1024, W + W_D1, 128, 0, nullptr, base);
            convert_weight(lds, p.w_in + (size_t)l * 1024 * 4096, 1024, 4096, W + W_IN, 128, 0, p.ln_mix + l * 1024, base);
            convert_weight(lds, p.w_out + (size_t)l * 1024 * 1024, 1024, 1024, W + W_OUT, 128, 0, nullptr, base);
            convert_weight(lds, p.w_xq + (size_t)l * 1024 * 1024, 1024, 1024, W + W_XQ, 128, 0, p.ln_xq + l * 1024, base);
            convert_weight(lds, p.w_xkv + (size_t)l * 1024 * 2048, 1024, 2048, W + W_XKV, 128, 0, p.ln_mem + l * 1024, base);
            convert_weight(lds, p.w_xo + (size_t)l * 1024 * 1024, 1024, 1024, W + W_XO, 128, 0, nullptr, base);
            convert_weight(lds, p.w2g + (size_t)l * 1024 * 2816, 1024, 2816, W + W_GU2, 256, 0, p.ln_ffn2 + l * 1024, base);
            convert_weight(lds, p.w2u + (size_t)l * 1024 * 2816, 1024, 2816, W + W_GU2, 256, 128, p.ln_ffn2 + l * 1024, base);
            convert_weight(lds, p.w2d + (size_t)l * 2816 * 1024, 2816, 1024, W + W_D2, 128, 0, nullptr, base); }
        convert_rows(p.x, HB, ROWSS, NTOK);
        convert_rows(p.mem, MEMB, MEMSS, 8192);
        for (size_t i = (size_t)blockIdx.x * 512 + tid; i < (size_t)8 * NTOK; i += (size_t)G * 512) ROWSS[NTOK + i] = 0.f;
        if (blockIdx.x == 0 && tid < 64) CTR[tid] = 0u;
    }
    grid.sync();
    pg8::StaticOrder S;
    for (int l = 0; l < 2; ++l) { S.init(8192, 2048, G, blockIdx.x);
        pg8::EpiMemKV E{(bf16_t*)(ws + WS_KX) + (size_t)l * 8192 * 1024, (bf16_t*)(ws + WS_VXT) + (size_t)l * 8192 * 1024, MEMSS};
        pg8::gemm_phase(lds, pg8::Gemm{MEMB, WB + (size_t)l * W_LAYER + W_XKV, 8192, 2048, 1024}, S, E); }

    for (int l = 0; l < 2; ++l) {
        const bf16_t* W = WB + (size_t)l * W_LAYER;
        { S.init(NTOK, 5632, G, blockIdx.x); pg8::EpiSwiglu E{BIG, ROWSS + (size_t)(4 * l + 0) * NTOK};
          pg8::gemm_phase(lds, pg8::Gemm{HB, W + W_GU1, NTOK, 5632, 1024}, S, E); }
        grid.sync();
        { S.init(NTOK, 1024, G, blockIdx.x); pg8::EpiRes E{l == 0 ? p.x : p.out, p.out, HB, ROWSS + (size_t)(4 * l + 1) * NTOK, 0.5f};
          pg8::gemm_phase(lds, pg8::Gemm{BIG, W + W_D1, NTOK, 1024, 2816}, S, E); }
        grid.sync();
        { S.init(NTOK, 4096, G, blockIdx.x); pg8::EpiScale E{BIG, 4096, ROWSS + (size_t)(4 * l + 1) * NTOK, 1.0f};
          pg8::gemm_phase(lds, pg8::Gemm{HB, W + W_IN, NTOK, 4096, 1024}, S, E); }
        grid.sync();
        {
#ifndef NO_HGRN
          for (int u = blockIdx.x; u < 128; u += G) hgrn_unit(lds, p, l, u);
#endif
          volatile LAS unsigned* bc = (volatile LAS unsigned*)(lds + LDS_BYTES - 16);
          for (;;) { if (tid == 0) *bc = atomicAdd(CTR + l, 1u); __syncthreads(); const unsigned u = *bc; __syncthreads(); if (u >= 2048u) break;
#ifndef NO_DATT
            dattn_unit(lds, p, (int)u);
#endif
          } }
        grid.sync();
        { S.init(NTOK, 1024, G, blockIdx.x); pg8::EpiRes E{p.out, p.out, HB, ROWSS + (size_t)(4 * l + 2) * NTOK, 1.0f};
          pg8::gemm_phase(lds, pg8::Gemm{YB, W + W_OUT, NTOK, 1024, 1024}, S, E); }
        grid.sync();
        { S.init(NTOK, 1024, G, blockIdx.x); pg8::EpiScale E{BIG, 1024, ROWSS + (size_t)(4 * l + 2) * NTOK, 0.0625f};
          pg8::gemm_phase(lds, pg8::Gemm{HB, W + W_XQ, NTOK, 1024, 1024}, S, E); }
        grid.sync();
        #ifndef NO_XATT
        for (int u = blockIdx.x; u < 1024; u += G) xattn_unit(p, l, u);
#endif
        grid.sync();
        { S.init(NTOK, 1024, G, blockIdx.x); pg8::EpiRes E{p.out, p.out, HB, ROWSS + (size_t)(4 * l + 3) * NTOK, 1.0f};
          pg8::gemm_phase(lds, pg8::Gemm{YB, W + W_XO, NTOK, 1024, 1024}, S, E); }
        grid.sync();
        { S.init(NTOK, 5632, G, blockIdx.x); pg8::EpiSwiglu E{BIG, ROWSS + (size_t)(4 * l + 3) * NTOK};
          pg8::gemm_phase(lds, pg8::Gemm{HB, W + W_GU2, NTOK, 5632, 1024}, S, E); }
        grid.sync();
        { S.init(NTOK, 1024, G, blockIdx.x); pg8::EpiRes E{p.out, p.out, HB, ROWSS + (size_t)(4 * l + 4) * NTOK, 0.5f};
          pg8::gemm_phase(lds, pg8::Gemm{BIG, W + W_D2, NTOK, 1024, 2816}, S, E); }
        grid.sync();
    }
    final_norm(p.out, ROWSS + (size_t)8 * NTOK, p.ln_final);
}

extern "C" void kernel_launch(void* const* d_in, const int* in_sizes, int n_in, void* d_out, int out_size, void* d_ws, size_t ws_size, hipStream_t stream) {
    static int grid_blocks = 0;
    if (!grid_blocks) {
        int dev = 0, cus = 0, per_cu = 0;
        hipGetDevice(&dev);
        hipDeviceGetAttribute(&cus, hipDeviceAttributeMultiprocessorCount, dev);
        if (hipFuncSetAttribute((const void*)fwd_megakernel, hipFuncAttributeMaxDynamicSharedMemorySize, LDS_BYTES) != hipSuccess) fprintf(stderr, "hipFuncSetAttribute failed\n");
        hipOccupancyMaxActiveBlocksPerMultiprocessor(&per_cu, (const void*)fwd_megakernel, 512, LDS_BYTES);
        if (per_cu < 1) per_cu = 1;
        grid_blocks = cus * per_cu;
        if (ws_size < WS_END) fprintf(stderr, "workspace too small: %zu < %zu\n", ws_size, (size_t)WS_END);
    }
    Params p{};
    const float** pp = (const float**)&p;
    for (int i = 0; i < 21; ++i) pp[i] = (const float*)d_in[i];
    p.out = (float*)d_out; p.ws = (uchar*)d_ws;
    void* args[] = {&p};
    hipError_t e = hipLaunchCooperativeKernel((const void*)fwd_megakernel, dim3(grid_blocks), dim3(512), args, LDS_BYTES, stream);
    if (e != hipSuccess) fprintf(stderr, "cooperative launch failed: %s (grid %d)\n", hipGetErrorString(e), grid_blocks);
}
```

```cpp
#ifndef PROBE_WHICH
#define PROBE_WHICH 0
#endif
#include <hip/hip_runtime.h>
#include <hip/hip_cooperative_groups.h>
#include <cstdio>
namespace cg = cooperative_groups;

#define LAS __attribute__((address_space(3)))
typedef unsigned short bf16_t;
typedef short bf16x8 __attribute__((ext_vector_type(8)));
typedef short s16x4 __attribute__((ext_vector_type(4)));
typedef float f32x4 __attribute__((ext_vector_type(4)));
typedef unsigned u32x4 __attribute__((ext_vector_type(4)));
typedef unsigned u32x2 __attribute__((ext_vector_type(2)));
typedef unsigned char uchar;

constexpr int D_MODEL = 1024, BATCH = 32, SEQ = 2048, NTOK = BATCH * SEQ, N_MEM = 256, D_FF = 2816, IN_COLS = 4096;
constexpr float EPS = 1e-6f;
constexpr int LDS_BYTES = 147456;

constexpr size_t WS_HB   = 0;
constexpr size_t WS_BIG  = WS_HB + (size_t)NTOK * 1024 * 2;
constexpr size_t WS_Y    = WS_BIG + (size_t)NTOK * 4096 * 2;
constexpr size_t WS_MEMB = WS_Y + (size_t)NTOK * 1024 * 2;
constexpr size_t WS_KX   = WS_MEMB + (size_t)8192 * 1024 * 2;
constexpr size_t WS_VXT  = WS_KX + (size_t)2 * 8192 * 1024 * 2;
constexpr size_t WS_W    = WS_VXT + (size_t)2 * 8192 * 1024 * 2;
constexpr size_t W_GU1 = 0, W_D1 = W_GU1 + (size_t)5632 * 1024, W_IN = W_D1 + (size_t)1024 * 2816, W_OUT = W_IN + (size_t)4096 * 1024,
                 W_XQ = W_OUT + (size_t)1024 * 1024, W_XKV = W_XQ + (size_t)1024 * 1024, W_XO = W_XKV + (size_t)2048 * 1024,
                 W_GU2 = W_XO + (size_t)1024 * 1024, W_D2 = W_GU2 + (size_t)5632 * 1024, W_LAYER = W_D2 + (size_t)1024 * 2816;
constexpr size_t WS_ROWSS = WS_W + 2 * W_LAYER * 2;
constexpr size_t WS_MEMSS = WS_ROWSS + (size_t)9 * NTOK * 16 * 4;
constexpr size_t WS_CTR   = WS_MEMSS + (size_t)8192 * 16 * 4;
constexpr size_t WS_BAR   = WS_CTR + 256;
constexpr size_t WS_END   = WS_BAR + 3456 * 4;

struct Params {
    const float *x, *mem, *ln_ffn1, *w1g, *w1u, *w1d, *ln_mix, *w_in, *lb_logits, *hgrn_gain, *w_out, *ln_xq, *ln_mem, *w_xq, *w_xkv, *w_xo, *ln_ffn2, *w2g, *w2u, *w2d, *ln_final;
    float* out; uchar* ws;
};

typedef __bf16 bf16x2_native __attribute__((ext_vector_type(2)));
typedef float f32x2_native __attribute__((ext_vector_type(2)));
__device__ __forceinline__ unsigned cvt_pk_bf16(float lo, float hi) { const f32x2_native v = {lo, hi}; return __builtin_bit_cast(unsigned, __builtin_convertvector(v, bf16x2_native)); }
__device__ __forceinline__ float bf2f(unsigned short b) { return __uint_as_float(((unsigned)b) << 16); }
__device__ __forceinline__ float bflo(unsigned u) { return __uint_as_float(u << 16); }
__device__ __forceinline__ float bfhi(unsigned u) { return __uint_as_float(u & 0xffff0000u); }
__device__ __forceinline__ float fast_rcp(float x) { return __builtin_amdgcn_rcpf(x); }
__device__ __forceinline__ float fast_exp(float x) { return __builtin_amdgcn_exp2f(x * 1.44269504089f); }
__device__ __forceinline__ float sigmoidf_(float x) { return fast_rcp(1.0f + fast_exp(-x)); }
__device__ __forceinline__ float siluf_(float x) { return x * sigmoidf_(x); }
__device__ __forceinline__ s16x4 tr_read(const LAS uchar* p) { typedef short v4i16_t __attribute__((ext_vector_type(4)));
    return __builtin_bit_cast(s16x4, __builtin_amdgcn_ds_read_tr16_b64_v4i16((LAS v4i16_t*)p)); }
__device__ __forceinline__ bf16x8 cat8(s16x4 lo, s16x4 hi) { bf16x8 r; r[0] = lo[0]; r[1] = lo[1]; r[2] = lo[2]; r[3] = lo[3]; r[4] = hi[0]; r[5] = hi[1]; r[6] = hi[2]; r[7] = hi[3]; return r; }
__device__ __forceinline__ bf16x8 pack8(f32x4 a, f32x4 b) { u32x4 w; w.x = cvt_pk_bf16(a[0], a[1]); w.y = cvt_pk_bf16(a[2], a[3]); w.z = cvt_pk_bf16(b[0], b[1]); w.w = cvt_pk_bf16(b[2], b[3]); return __builtin_bit_cast(bf16x8, w); }
__device__ __forceinline__ int lane_id() { int l; asm volatile("v_mbcnt_lo_u32_b32 %0, -1, 0\n\tv_mbcnt_hi_u32_b32 %0, -1, %0" : "=v"(l)); return l; }
#define TIDX (wb + lane_id())
__device__ __forceinline__ f32x4 mfma16(bf16x8 a, bf16x8 b, f32x4 c) { return __builtin_amdgcn_mfma_f32_16x16x32_bf16(a, b, c, 0, 0, 0); }

namespace pg8 {
constexpr int BM = 256, BK = 64, HALF = 128, HTB = HALF * BK * 2, STAGE_BYTES = 8 * HTB, NXCD = 8, WGM = 8;
__host__ __device__ __forceinline__ int lds_byte(int r, int c) { const int st = (r >> 4) * 2 + (c >> 5), rr = r & 15, cc = c & 31, ob = rr * 64 + cc * 2; return st * 1024 + (ob ^ (((ob >> 9) & 1) << 5)); }
__host__ __device__ __forceinline__ void stage_rc(int b, int& R, int& C) { const int st = b / 1024, sb = b % 1024, swz = sb ^ (((sb >> 9) & 1) << 5); R = (st >> 1) * 16 + swz / 64; C = (st & 1) * 32 + (swz % 64) / 2; }
__host__ __device__ __forceinline__ int perm32(int rho) { const int n = rho >> 4, i = rho & 15; return 8 * (i >> 2) + 4 * n + (i & 3); }
struct Unit { int pm, pn; };
struct Gemm { const bf16_t* A; const bf16_t* Bt; int M, N, K; };
struct StaticOrder {
    int nM, nN, nwg, G, c;
    __device__ void init(int M, int N, int G_, int c_) { nM = M / BM; nN = N / BM; nwg = nM * nN; G = G_; c = c_; asm volatile("" : "+s"(c), "+s"(nwg)); }
    __device__ bool next(int i, Unit& u) const {
        const long L = (long)i * G + c; if (L >= nwg) return false;
        int wgid = (int)L; { const int q = nwg / NXCD, r = nwg % NXCD, xcd = wgid % NXCD, off = wgid / NXCD; wgid = (xcd < r ? xcd * (q + 1) : r * (q + 1) + (xcd - r) * q) + off; }
        const int nig = WGM * nN, gid = wgid / nig, fm = gid * WGM, gsz = (nM - fm) < WGM ? (nM - fm) : WGM;
        u.pm = fm + ((wgid % nig) % gsz); u.pn = (wgid % nig) / gsz; return true;
    }
};

struct XqOrder { int pm0, pn; __device__ bool next(int i, Unit& u) const { if (i >= 4) return false; u.pm = pm0 + i; u.pn = pn; return true; } };

template <class Epi, class Sched>
__device__ __forceinline__ void gemm_phase(LAS uchar* lds, const Gemm g, const Sched& S, const Epi& E, int wb) {
    int tid = TIDX; asm volatile("" : "+v"(tid));
    const int wid = __builtin_amdgcn_readfirstlane(tid >> 6), lane = tid & 63, wr = wid >> 2, wc = wid & 3, fr = lane & 15, fq = lane >> 4;
    int K = g.K; const bf16_t* gA = g.A; const bf16_t* gBt = g.Bt;
    asm volatile("" : "+s"(K), "+s"(gA), "+s"(gBt));
    const int nt = K / BK;
    unsigned voffA[2], voffB[2];
#pragma unroll
    for (int i = 0; i < 2; ++i) { int R, C; stage_rc(tid * 16 + i * 8192, R, C); const int Rb = Epi::PERM ? ((R & ~31) + perm32(R & 31)) : R;
        voffA[i] = (unsigned)(R * K + C) * 2u; voffB[i] = (unsigned)(Rb * K + C) * 2u; }
    const size_t kstep = (size_t)(BK * 2);
    const size_t hstep = (size_t)HALF * K * 2;
    const size_t tstep = 2 * hstep;
    const unsigned ldsw = (unsigned)wid * 1024u;
    const int aoff = lds_byte(wr * 64 + fr, fq * 8), boff = lds_byte(wc * 32 + fr, fq * 8);
#define PG8_SA(b, h) (((b) * 2 + (h)) * HTB)
#define PG8_SB(b, h) ((4 + (b) * 2 + (h)) * HTB)
#define PG8_STAGE(bufoff, gbase, voff) do { _Pragma("unroll") for (int _i = 0; _i < 2; ++_i) \
        __builtin_amdgcn_global_load_lds((const unsigned*)((const char*)(gbase) + (voff)[_i]), (LAS unsigned*)(lds + (bufoff) + ldsw + _i * 8192), 16, 0, 0); } while (0)
#define PG8_LDA(dst, b, h) do { _Pragma("unroll") for (int m = 0; m < 4; ++m) _Pragma("unroll") for (int k = 0; k < 2; ++k) dst[m][k] = *(const LAS bf16x8*)(lds + PG8_SA(b, h) + aoff + m * 2048 + k * 1024); } while (0)
#define PG8_LDB(dst, b, h) do { _Pragma("unroll") for (int n = 0; n < 2; ++n) _Pragma("unroll") for (int k = 0; k < 2; ++k) dst[n][k] = *(const LAS bf16x8*)(lds + PG8_SB(b, h) + boff + n * 2048 + k * 1024); } while (0)
#define PG8_MMA(ai, bj, At, Bt) do { __builtin_amdgcn_s_setprio(1); _Pragma("unroll") for (int m = 0; m < 4; ++m) _Pragma("unroll") for (int n = 0; n < 2; ++n) _Pragma("unroll") for (int k = 0; k < 2; ++k) \
        acc[ai][bj][m][n] = __builtin_amdgcn_mfma_f32_16x16x32_bf16(Bt[n][k], At[m][k], acc[ai][bj][m][n], 0, 0, 0); __builtin_amdgcn_s_setprio(0); } while (0)
#define PG8_WAIT_V(n) asm volatile("s_waitcnt vmcnt(" #n ")" ::: "memory")
#define PG8_WAIT_L(n) asm volatile("s_waitcnt lgkmcnt(" #n ")" ::: "memory")
#define PG8_BAR __builtin_amdgcn_s_barrier()
#define PG8_SCHED __builtin_amdgcn_sched_barrier(0)
    Unit cur, nxt; int ui = 0;
    if (!S.next(0, cur)) return;
    f32x4 acc[2][2][4][2];
#pragma unroll
    for (int a = 0; a < 2; ++a)
#pragma unroll
        for (int b = 0; b < 2; ++b)
#pragma unroll
            for (int m = 0; m < 4; ++m)
#pragma unroll
                for (int n = 0; n < 2; ++n) acc[a][b][m][n] = (f32x4){0.f, 0.f, 0.f, 0.f};
    bf16x8 At[4][2], B0[2][2], B1[2][2];
    const char* cA = (const char*)gA + (size_t)cur.pm * tstep; const char* cB = (const char*)gBt + (size_t)cur.pn * tstep;
    PG8_STAGE(PG8_SB(0, 0), cB, voffB); PG8_STAGE(PG8_SA(0, 0), cA, voffA); PG8_STAGE(PG8_SB(0, 1), cB + hstep, voffB); PG8_STAGE(PG8_SA(0, 1), cA + hstep, voffA);
    if (wr == 1) PG8_BAR;
    PG8_WAIT_V(4); PG8_BAR;
    PG8_STAGE(PG8_SB(1, 0), cB + kstep, voffB); PG8_STAGE(PG8_SA(1, 0), cA + kstep, voffA); PG8_STAGE(PG8_SB(1, 1), cB + hstep + kstep, voffB);
    PG8_WAIT_V(6); PG8_BAR;
    for (;;) {
        const bool has_next = S.next(ui + 1, nxt);
        const char* nA = has_next ? (const char*)gA + (size_t)nxt.pm * tstep : cA; const char* nB = has_next ? (const char*)gBt + (size_t)nxt.pn * tstep : cB;
        for (int t = 0; t < nt; t += 2) {
            const bool last = (t == nt - 2);
            const char* a1 = cA + (size_t)(t + 1) * kstep;
            const char* a2 = last ? nA : cA + (size_t)(t + 2) * kstep; const char* b2 = last ? nB : cB + (size_t)(t + 2) * kstep;
            const char* a3 = a2 + kstep; const char* b3 = b2 + kstep;
            PG8_LDB(B0, 0, 0); PG8_SCHED; PG8_LDA(At, 0, 0); PG8_STAGE(PG8_SA(1, 1), a1 + hstep, voffA);
            PG8_WAIT_L(8); PG8_BAR; PG8_WAIT_L(0); PG8_MMA(0, 0, At, B0); PG8_BAR; PG8_SCHED;
            PG8_LDB(B1, 0, 1); PG8_STAGE(PG8_SB(0, 0), b2, voffB);
            PG8_BAR; PG8_WAIT_L(0); PG8_MMA(0, 1, At, B1); PG8_BAR;
            PG8_LDA(At, 0, 1); PG8_STAGE(PG8_SA(0, 0), a2, voffA);
            PG8_BAR; PG8_WAIT_L(0); PG8_MMA(1, 0, At, B0); PG8_BAR; PG8_SCHED;
            PG8_STAGE(PG8_SB(0, 1), b2 + hstep, voffB);
            PG8_WAIT_V(6); PG8_BAR; PG8_MMA(1, 1, At, B1); PG8_BAR;
            PG8_LDB(B0, 1, 0); PG8_SCHED; PG8_LDA(At, 1, 0); PG8_STAGE(PG8_SA(0, 1), a2 + hstep, voffA);
            PG8_WAIT_L(8); PG8_BAR; PG8_WAIT_L(0); PG8_MMA(0, 0, At, B0); PG8_BAR; PG8_SCHED;
            PG8_LDB(B1, 1, 1); PG8_STAGE(PG8_SB(1, 0), b3, voffB);
            PG8_BAR; PG8_WAIT_L(0); PG8_MMA(0, 1, At, B1); PG8_BAR;
            PG8_LDA(At, 1, 1); PG8_STAGE(PG8_SA(1, 0), a3, voffA);
            PG8_BAR; PG8_WAIT_L(0); PG8_MMA(1, 0, At, B0); PG8_BAR; PG8_SCHED;
            PG8_STAGE(PG8_SB(1, 1), b3 + hstep, voffB);
            PG8_WAIT_V(6); PG8_BAR; PG8_MMA(1, 1, At, B1); PG8_BAR;
        }
        { int te = TIDX; asm volatile("" : "+v"(te));
          const int we = __builtin_amdgcn_readfirstlane(te >> 6), le = te & 63; E(acc, cur, we >> 2, we & 3, le & 15, le >> 4); }
        if (!has_next) break;
#pragma unroll
        for (int a = 0; a < 2; ++a)
#pragma unroll
            for (int b = 0; b < 2; ++b)
#pragma unroll
                for (int m = 0; m < 4; ++m)
#pragma unroll
                    for (int n = 0; n < 2; ++n) acc[a][b][m][n] = (f32x4){0.f, 0.f, 0.f, 0.f};
        cur = nxt; cA = nA; cB = nB; ++ui;
    }
    PG8_WAIT_V(0);
    if (wr == 0) PG8_BAR;
    PG8_BAR;
#undef PG8_SA
#undef PG8_SB
#undef PG8_STAGE
#undef PG8_LDA
#undef PG8_LDB
#undef PG8_MMA
#undef PG8_WAIT_V
#undef PG8_WAIT_L
#undef PG8_BAR
#undef PG8_SCHED
}

__device__ __forceinline__ float row_rstd(const float* ss, int row) { const f32x4* q = (const f32x4*)(ss + (size_t)row * 16); const f32x4 a = q[0], b = q[1], c = q[2], d = q[3];
    const float t = (((a[0] + a[1]) + (a[2] + a[3])) + ((b[0] + b[1]) + (b[2] + b[3]))) + (((c[0] + c[1]) + (c[2] + c[3])) + ((d[0] + d[1]) + (d[2] + d[3])));
    return __builtin_amdgcn_rsqf(t * (1.0f / 1024.0f) + EPS); }

__device__ __forceinline__ float row_rstd4(const float* ss, int row, int fq) { const f32x4 a = *(const f32x4*)(ss + (size_t)row * 16 + 4 * fq);
    float t = (a[0] + a[1]) + (a[2] + a[3]); t += __shfl_xor(t, 16); t += __shfl_xor(t, 32);
    return __builtin_amdgcn_rsqf(t * (1.0f / 1024.0f) + EPS); }
struct EpiSwiglu {
    static constexpr bool PERM = true;
    bf16_t* O; const float* rowss;
    __device__ __forceinline__ void operator()(const f32x4 (&acc)[2][2][4][2], const Unit& u, int wr, int wc, int fr, int fq) const {
        const int row0 = u.pm * BM + wr * 64 + fr, col0 = u.pn * 128 + wc * 32 + 8 * fq;
        float rsv[2][4];
#pragma unroll
        for (int ai = 0; ai < 2; ++ai)
#pragma unroll
            for (int m = 0; m < 4; ++m) rsv[ai][m] = row_rstd4(rowss, row0 + ai * HALF + m * 16, fq);
#pragma unroll
        for (int ai = 0; ai < 2; ++ai)
#pragma unroll
            for (int m = 0; m < 4; ++m) { const int row = row0 + ai * HALF + m * 16; const float rs = rsv[ai][m];
                f32x4 o0, o1;
#pragma unroll
                for (int j = 0; j < 4; ++j) { o0[j] = siluf_(acc[ai][0][m][0][j] * rs) * (acc[ai][1][m][0][j] * rs); o1[j] = siluf_(acc[ai][0][m][1][j] * rs) * (acc[ai][1][m][1][j] * rs); }
                *(bf16x8*)(O + (size_t)row * D_FF + col0) = pack8(o0, o1); }
    }
};
struct EpiRes {
    static constexpr bool PERM = true;
    bf16_t* hb; float* rowss_next; float scale;
    __device__ __forceinline__ void operator()(const f32x4 (&acc)[2][2][4][2], const Unit& u, int wr, int wc, int fr, int fq) const {
        const int row0 = u.pm * BM + wr * 64 + fr, col0 = u.pn * BM + wc * 32 + 8 * fq;
        u32x4 rv[2][4][2];
#pragma unroll
        for (int ai = 0; ai < 2; ++ai)
#pragma unroll
            for (int m = 0; m < 4; ++m)
#pragma unroll
                for (int bj = 0; bj < 2; ++bj) rv[ai][m][bj] = *(const u32x4*)(hb + (size_t)(row0 + ai * HALF + m * 16) * D_MODEL + col0 + bj * HALF);
#pragma unroll
        for (int ai = 0; ai < 2; ++ai)
#pragma unroll
            for (int m = 0; m < 4; ++m) { const int row = row0 + ai * HALF + m * 16; float ss = 0.f;
#pragma unroll
                for (int bj = 0; bj < 2; ++bj) { const size_t idx = (size_t)row * D_MODEL + col0 + bj * HALF;
                    const u32x4 r = rv[ai][m][bj];
                    f32x4 h0, h1;
                    h0[0] = bflo(r.x) + acc[ai][bj][m][0][0] * scale; h0[1] = bfhi(r.x) + acc[ai][bj][m][0][1] * scale; h0[2] = bflo(r.y) + acc[ai][bj][m][0][2] * scale; h0[3] = bfhi(r.y) + acc[ai][bj][m][0][3] * scale;
                    h1[0] = bflo(r.z) + acc[ai][bj][m][1][0] * scale; h1[1] = bfhi(r.z) + acc[ai][bj][m][1][1] * scale; h1[2] = bflo(r.w) + acc[ai][bj][m][1][2] * scale; h1[3] = bfhi(r.w) + acc[ai][bj][m][1][3] * scale;
                    *(bf16x8*)(hb + idx) = pack8(h0, h1);
#pragma unroll
                    for (int j = 0; j < 4; ++j) ss += h0[j] * h0[j] + h1[j] * h1[j]; }
                ss += __shfl_xor(ss, 16); ss += __shfl_xor(ss, 32);
                if (fq == 0) rowss_next[(size_t)row * 16 + u.pn * 4 + wc] = ss; }
    }
};
struct EpiScale {
    static constexpr bool PERM = true;
    bf16_t* O; int ldo; const float* rowss; float cs;
    __device__ __forceinline__ void operator()(const f32x4 (&acc)[2][2][4][2], const Unit& u, int wr, int wc, int fr, int fq) const {
        const int row0 = u.pm * BM + wr * 64 + fr, col0 = u.pn * BM + wc * 32 + 8 * fq;
        float rsv[2][4];
#pragma unroll
        for (int ai = 0; ai < 2; ++ai)
#pragma unroll
            for (int m = 0; m < 4; ++m) rsv[ai][m] = row_rstd4(rowss, row0 + ai * HALF + m * 16, fq);
#pragma unroll
        for (int ai = 0; ai < 2; ++ai)
#pragma unroll
            for (int m = 0; m < 4; ++m) { const int row = row0 + ai * HALF + m * 16; const float rs = rsv[ai][m] * cs;
#pragma unroll
                for (int bj = 0; bj < 2; ++bj) *(bf16x8*)(O + (size_t)row * ldo + col0 + bj * HALF) = pack8(acc[ai][bj][m][0] * rs, acc[ai][bj][m][1] * rs); }
    }
};
struct EpiMemKV {
    static constexpr bool PERM = true;
    bf16_t* KX; bf16_t* VXT; const float* rowss;
    __device__ __forceinline__ void operator()(const f32x4 (&acc)[2][2][4][2], const Unit& u, int wr, int wc, int fr, int fq) const {
        const int row0 = u.pm * BM + wr * 64 + fr, col0 = u.pn * BM + wc * 32 + 8 * fq;
#pragma unroll
        for (int ai = 0; ai < 2; ++ai)
#pragma unroll
            for (int m = 0; m < 4; ++m) { const int row = row0 + ai * HALF + m * 16; const float rs = row_rstd(rowss, row);
#pragma unroll
                for (int bj = 0; bj < 2; ++bj) { const int col = col0 + bj * HALF;
                    if (u.pn < 4) { *(bf16x8*)(KX + (size_t)row * 1024 + col) = pack8(acc[ai][bj][m][0] * rs, acc[ai][bj][m][1] * rs); }
                    else { const int j0 = row & 255, jrow = (j0 & ~31) | (8 * ((j0 >> 2) & 3) + 4 * ((j0 >> 4) & 1) + (j0 & 3));
                        bf16_t* vp = VXT + ((size_t)u.pm * 1024 + (col - 1024)) * 256 + jrow;
#pragma unroll
                        for (int n = 0; n < 2; ++n)
#pragma unroll
                            for (int j = 0; j < 4; ++j) vp[(size_t)(4 * n + j) * 256] = (bf16_t)(cvt_pk_bf16(acc[ai][bj][m][n][j] * rs, 0.f) & 0xffffu); } } }
    }
};
}

__device__ __forceinline__ void convert_tile(LAS uchar* lds, const float* W, int K, int N, bf16_t* dst, int rs, int off, const float* gain, int tile, int wb) {
    int tid = TIDX; asm volatile("" : "+v"(tid)); LAS float* T = (LAS float*)lds;
    const int ntn = N >> 8, tk = tile / ntn, tn = tile - tk * ntn, k0 = tk * 64, n0 = tn * 256;
    { const int kk = tid >> 3, c8 = (tid & 7) * 8; const float* src = W + (size_t)(k0 + kk) * N + n0 + c8; const float gk = gain ? gain[k0 + kk] : 1.0f;
      f32x4 a[4], b[4];
#pragma unroll
      for (int q = 0; q < 4; ++q) { a[q] = *(const f32x4*)(src + 64 * q); b[q] = *(const f32x4*)(src + 64 * q + 4); }
#pragma unroll
      for (int q = 0; q < 4; ++q)
#pragma unroll
          for (int j = 0; j < 4; ++j) { T[q * 4160 + kk * 65 + c8 + j] = a[q][j] * gk; T[q * 4160 + kk * 65 + c8 + 4 + j] = b[q][j] * gk; } }
    __syncthreads();
    { const int n = tid >> 3, k8 = (tid & 7) * 8;
#pragma unroll
      for (int q = 0; q < 4; ++q) { f32x4 a, b;
#pragma unroll
          for (int j = 0; j < 4; ++j) { a[j] = T[q * 4160 + (k8 + j) * 65 + n]; b[j] = T[q * 4160 + (k8 + 4 + j) * 65 + n]; }
          const int nn = n0 + 64 * q + n, drow = (nn >> 7) * rs + (nn & 127) + off;
          *(bf16x8*)(dst + (size_t)drow * K + k0 + k8) = pack8(a, b); } }
    __syncthreads();
}
__device__ __forceinline__ void convert_weight(LAS uchar* lds, const float* W, int K, int N, bf16_t* dst, int rs, int off, const float* gain, int& base, int wb) {
    const int G = gridDim.x, nt = (K >> 6) * (N >> 8);
    for (int t = (int)((blockIdx.x + G - (base % G)) % G); t < nt; t += G) convert_tile(lds, W, K, N, dst, rs, off, gain, t, wb);
    base += nt;
}
__device__ __forceinline__ void convert_rows(const float* __restrict__ X, bf16_t* __restrict__ Xb, float* __restrict__ ss, int nrows, int wb) {
    int tid_ = TIDX; asm volatile("" : "+v"(tid_));
    const int lane = tid_ & 63, gw = blockIdx.x * 8 + (tid_ >> 6), nw = gridDim.x * 8;
    for (int r0 = gw * 4; r0 < nrows; r0 += nw * 4) {
        f32x4 v[4][4];
#pragma unroll
        for (int q = 0; q < 4; ++q)
#pragma unroll
            for (int i = 0; i < 4; ++i) v[q][i] = *(const f32x4*)(X + (size_t)(r0 + q) * 1024 + i * 256 + lane * 4);
#pragma unroll
        for (int q = 0; q < 4; ++q) { bf16_t* dp = Xb + (size_t)(r0 + q) * 1024; float s = 0.f;
#pragma unroll
            for (int i = 0; i < 4; ++i) { const f32x4 x = v[q][i]; s += x[0] * x[0] + x[1] * x[1] + x[2] * x[2] + x[3] * x[3];
                u32x2 w; w.x = cvt_pk_bf16(x[0], x[1]); w.y = cvt_pk_bf16(x[2], x[3]); *(u32x2*)(dp + i * 256 + lane * 4) = w; }
#pragma unroll
            for (int o = 32; o >= 1; o >>= 1) s += __shfl_xor(s, o);
            if (lane < 16) ss[(size_t)(r0 + q) * 16 + lane] = lane == 0 ? s : 0.f; } }
}
__device__ __forceinline__ void final_norm(float* __restrict__ out, const bf16_t* __restrict__ hb, const float* __restrict__ ss, const float* __restrict__ gain, size_t nprobe, int wb) {
    int tid_ = TIDX; asm volatile("" : "+v"(tid_));
    const int lane = tid_ & 63, gw = blockIdx.x * 8 + (tid_ >> 6), nw = gridDim.x * 8;
    f32x4 gv[4];
#pragma unroll
    for (int i = 0; i < 4; ++i) gv[i] = *(const f32x4*)(gain + i * 256 + lane * 4);
    for (int r0 = gw * 4; r0 < NTOK; r0 += nw * 4) {
        u32x2 hv[4][4]; float rs[4];
#pragma unroll
        for (int q = 0; q < 4; ++q) { rs[q] = pg8::row_rstd(ss, r0 + q);
#pragma unroll
            for (int i = 0; i < 4; ++i) hv[q][i] = *(const u32x2*)(hb + (size_t)(r0 + q) * 1024 + i * 256 + lane * 4); }
#pragma unroll
        for (int q = 0; q < 4; ++q) { float* p = out + (size_t)(r0 + q) * 1024;
#pragma unroll
            for (int i = 0; i < 4; ++i) { f32x4 v; v[0] = bflo(hv[q][i].x); v[1] = bfhi(hv[q][i].x); v[2] = bflo(hv[q][i].y); v[3] = bfhi(hv[q][i].y); v = v * rs[q] * gv[i];
#if PROBE_WHICH
                { const size_t li = (size_t)(r0 + q) * 1024 + i * 256 + lane * 4;
#pragma unroll
                  for (int j = 0; j < 4; ++j) if (li + j < nprobe) v[j] += 0.0625f; }
#endif
                *(f32x4*)(p + i * 256 + lane * 4) = v; } } }
}

constexpr int HG_ROW = 272, HG_PROW = 144;
constexpr int HG_QD = 0, HG_KD = 64 * HG_ROW, HG_VV = 2 * 64 * HG_ROW, HG_PP = 3 * 64 * HG_ROW, HG_SREF = HG_PP + 64 * HG_PROW, HG_SE2 = HG_SREF + 512, HG_RED = HG_SE2 + 512, HG_DIR_BYTES = HG_RED + 1024;
static_assert(2 * HG_DIR_BYTES <= LDS_BYTES - 64, "hgrn lds");

__device__ void hgrn_unit(LAS uchar* lds_all, const Params& p, int layer, int unit, int wb) {
    int tid = TIDX; asm volatile("" : "+v"(tid));
    const int lane = tid & 63, wid = __builtin_amdgcn_readfirstlane(tid >> 6), dir = wid >> 2, w = wid & 3, dtid = tid & 255;
    const int fr = lane & 15, g = lane >> 4, q_ = fr >> 2, p_ = fr & 3;
    const int b = unit >> 2, hd = unit & 3;
    LAS uchar* L = lds_all + dir * HG_DIR_BYTES;
    const bf16_t* proj = (const bf16_t*)(p.ws + WS_BIG) + (size_t)b * SEQ * IN_COLS;
    float* tmp = p.out + (size_t)b * SEQ * 512;
    bf16_t* Y = (bf16_t*)(p.ws + WS_Y) + (size_t)b * SEQ * 1024;
    const int pk = dtid & 127, half = __builtin_amdgcn_readfirstlane(dtid >> 7);
    float lb = 0.f;
    if (layer == 1) { const float l0 = p.lb_logits[(0 * 2 + dir) * 512 + hd * 128 + pk], l1 = p.lb_logits[(1 * 2 + dir) * 512 + hd * 128 + pk]; lb = sigmoidf_(l1 - l0); }
    const float omlb = 1.0f - lb;
    const int zcol = 1024 + dir * 512 + hd * 128 + pk, qcol = hd * 128 + pk;

    f32x4 sacc[8][2];
#pragma unroll
    for (int kt = 0; kt < 8; ++kt) { sacc[kt][0] = (f32x4){0.f, 0.f, 0.f, 0.f}; sacc[kt][1] = (f32x4){0.f, 0.f, 0.f, 0.f}; }

    unsigned short zr[32], qr[32];
#define HG_PREFETCH(stp, i0, i1) do { const int _t0 = (dir == 0 ? (stp) : 31 - (stp)) * 64; \
        _Pragma("unroll") for (int i = (i0); i < (i1); ++i) { const int tau = half ? 32 + i : 31 - i; const int tl = dir == 0 ? tau : 63 - tau; const unsigned ro = (unsigned)((_t0 + tl) * IN_COLS) * 2u; \
            zr[i] = *(const bf16_t*)((const char*)proj + ro + zcol * 2); qr[i] = *(const bf16_t*)((const char*)proj + ro + qcol * 2); } } while (0)
    constexpr int HG_PF = 24;
    HG_PREFETCH(0, 0, HG_PF);
    for (int step = 0; step < 32; ++step) {
        const int tok0 = (dir == 0 ? step : 31 - step) * 64;
        {
            u32x4 vrow[4];
            { const int rowi = dtid >> 2, seg = dtid & 3; const unsigned so = (unsigned)((tok0 + rowi) * IN_COLS + 512 + hd * 128 + seg * 32) * 2u;
#pragma unroll
              for (int i = 0; i < 4; ++i) vrow[i] = *(const u32x4*)((const char*)proj + so + i * 16); }
            HG_PREFETCH(step, HG_PF, 32);
            float E = 1.0f;
#pragma unroll
            for (int i = 0; i < 32; ++i) { const int tau = half ? 32 + i : 31 - i;
                const float z = bf2f(zr[i]), q = bf2f(qr[i]); const float s = sigmoidf_(z), f = lb + omlb * s, kk = omlb * (1.0f - s);
                float qd, kd;
                if (half) { E = fmaxf(E * f, 1e-30f); qd = q * E; kd = kk * fast_rcp(E); }
                else { qd = q * fast_rcp(E); kd = kk * E; E = fmaxf(E * f, 1e-30f); }
                *(LAS bf16_t*)(L + HG_QD + tau * HG_ROW + pk * 2) = (bf16_t)(cvt_pk_bf16(qd, 0.f) & 0xffffu);
                *(LAS bf16_t*)(L + HG_KD + tau * HG_ROW + pk * 2) = (bf16_t)(cvt_pk_bf16(kd, 0.f) & 0xffffu); }
            *(LAS float*)(L + (half ? HG_SE2 : HG_SREF) + pk * 4) = E;
            { const int rowi = dtid >> 2, seg = dtid & 3, tau = dir == 0 ? rowi : 63 - rowi;
#pragma unroll
              for (int i = 0; i < 4; ++i) *(LAS u32x4*)(L + HG_VV + tau * HG_ROW + seg * 64 + i * 16) = vrow[i]; }
        }
        __syncthreads();
        bf16x8 qbs[4];
#pragma unroll
        for (int ks = 0; ks < 4; ++ks) qbs[ks] = *(const LAS bf16x8*)(L + HG_QD + (16 * w + fr) * HG_ROW + (32 * ks + 8 * g) * 2);
#pragma unroll
        for (int st = 0; st < 4; ++st) { f32x4 a = (f32x4){0.f, 0.f, 0.f, 0.f};
            if (st <= w) { bf16x8 kas[4];
#pragma unroll
                for (int ks = 0; ks < 4; ++ks) kas[ks] = *(const LAS bf16x8*)(L + HG_KD + (16 * st + fr) * HG_ROW + (32 * ks + 8 * g) * 2);
#pragma unroll
                for (int ks = 0; ks < 4; ++ks) a = mfma16(kas[ks], qbs[ks], a);
#pragma unroll
                for (int r = 0; r < 4; ++r) if (16 * st + 4 * g + r > 16 * w + fr) a[r] = 0.f; }
            u32x2 pw; pw.x = cvt_pk_bf16(a[0], a[1]); pw.y = cvt_pk_bf16(a[2], a[3]);
            *(LAS u32x2*)(L + HG_PP + (16 * w + fr) * HG_PROW + (16 * st + 4 * g) * 2) = pw; }
#pragma unroll
        for (int kt = 0; kt < 8; ++kt) { const f32x4 sr = *(const LAS f32x4*)(L + HG_SREF + (16 * kt + 4 * g) * 4); sacc[kt][0] *= sr; sacc[kt][1] *= sr; }
        bf16x8 vf[2][2];
#pragma unroll
        for (int vt = 0; vt < 2; ++vt)
#pragma unroll
            for (int ks = 0; ks < 2; ++ks) { const LAS uchar* a = L + HG_VV + (32 * ks + 8 * g + q_) * HG_ROW + (32 * w + 16 * vt + 4 * p_) * 2; vf[vt][ks] = cat8(tr_read(a), tr_read(a + 4 * HG_ROW)); }
        __syncthreads();
        if (step + 1 < 32) { HG_PREFETCH(step + 1, 0, HG_PF); }
        f32x4 oacc[2][4];
#pragma unroll
        for (int vt = 0; vt < 2; ++vt)
#pragma unroll
            for (int tt = 0; tt < 4; ++tt) oacc[vt][tt] = (f32x4){0.f, 0.f, 0.f, 0.f};
        { bf16x8 pbs[4][2];
#pragma unroll
          for (int tt = 0; tt < 4; ++tt)
#pragma unroll
              for (int ks = 0; ks < 2; ++ks) pbs[tt][ks] = *(const LAS bf16x8*)(L + HG_PP + (16 * tt + fr) * HG_PROW + (32 * ks + 8 * g) * 2);
          __builtin_amdgcn_sched_barrier(0);
#pragma unroll
          for (int tt = 0; tt < 4; ++tt)
#pragma unroll
              for (int ks = 0; ks < 2; ++ks) { oacc[0][tt] = mfma16(vf[0][ks], pbs[tt][ks], oacc[0][tt]); oacc[1][tt] = mfma16(vf[1][ks], pbs[tt][ks], oacc[1][tt]); } }
#pragma unroll
        for (int ks = 0; ks < 4; ++ks) { const bf16x8 sa0 = pack8(sacc[2 * ks][0], sacc[2 * ks + 1][0]), sa1 = pack8(sacc[2 * ks][1], sacc[2 * ks + 1][1]);
            u32x2 qlo[4], qhi[4];
#pragma unroll
            for (int tt = 0; tt < 4; ++tt) { const LAS uchar* qa = L + HG_QD + (16 * tt + fr) * HG_ROW + (32 * ks + 4 * g) * 2; qlo[tt] = *(const LAS u32x2*)qa; qhi[tt] = *(const LAS u32x2*)(qa + 32); }
#pragma unroll
            for (int tt = 0; tt < 4; ++tt) { u32x4 qq; qq.x = qlo[tt].x; qq.y = qlo[tt].y; qq.z = qhi[tt].x; qq.w = qhi[tt].y;
                const bf16x8 qb = __builtin_bit_cast(bf16x8, qq);
                oacc[0][tt] = mfma16(sa0, qb, oacc[0][tt]); oacc[1][tt] = mfma16(sa1, qb, oacc[1][tt]); } }
#pragma unroll
        for (int kt = 0; kt < 8; ++kt) {
            s16x4 t0[2], t1[2];
#pragma unroll
            for (int ks = 0; ks < 2; ++ks) { const LAS uchar* a = L + HG_KD + (32 * ks + 8 * g + q_) * HG_ROW + (16 * kt + 4 * p_) * 2; t0[ks] = tr_read(a); t1[ks] = tr_read(a + 4 * HG_ROW); }
            const f32x4 e2 = *(const LAS f32x4*)(L + HG_SE2 + (16 * kt + 4 * g) * 4);
#pragma unroll
            for (int ks = 0; ks < 2; ++ks) { const bf16x8 ka = cat8(t0[ks], t1[ks]);
                sacc[kt][0] = mfma16(ka, vf[0][ks], sacc[kt][0]); sacc[kt][1] = mfma16(ka, vf[1][ks], sacc[kt][1]); }
            sacc[kt][0] *= e2; sacc[kt][1] *= e2; }
        const bool second = step >= 16;
        float ssq[4];
#pragma unroll
        for (int tt = 0; tt < 4; ++tt) { const int tau = 16 * tt + fr, tl = dir == 0 ? tau : 63 - tau; float s = 0.f;
#pragma unroll
            for (int vt = 0; vt < 2; ++vt) { float* tp = tmp + (size_t)(tok0 + tl) * 512 + hd * 128 + 32 * w + 16 * vt + 4 * g;
                if (!second) *(f32x4*)tp = oacc[vt][tt];
                else { oacc[vt][tt] += *(const f32x4*)tp; const f32x4 o = oacc[vt][tt]; s += o[0] * o[0] + o[1] * o[1] + o[2] * o[2] + o[3] * o[3]; } }
            ssq[tt] = s; }
        if (second) {
#pragma unroll
            for (int tt = 0; tt < 4; ++tt) { float s = ssq[tt]; s += __shfl_xor(s, 16); s += __shfl_xor(s, 32); if (g == 0) *(LAS float*)(L + HG_RED + (w * 64 + 16 * tt + fr) * 4) = s; } }
        __syncthreads();
        if (second) {
#pragma unroll
            for (int tt = 0; tt < 4; ++tt) { const int tau = 16 * tt + fr, tl = dir == 0 ? tau : 63 - tau;
                const float tot = *(const LAS float*)(L + HG_RED + tau * 4) + *(const LAS float*)(L + HG_RED + (64 + tau) * 4) + *(const LAS float*)(L + HG_RED + (128 + tau) * 4) + *(const LAS float*)(L + HG_RED + (192 + tau) * 4);
                const float rs = __builtin_amdgcn_rsqf(tot * (1.0f / 128.0f) + EPS);
#pragma unroll
                for (int vt = 0; vt < 2; ++vt) { const int v = hd * 128 + 32 * w + 16 * vt + 4 * g;
                    const f32x4 gn = *(const f32x4*)(p.hgrn_gain + layer * 512 + v);
                    const u32x2 gt = *(const u32x2*)(proj + (size_t)(tok0 + tl) * IN_COLS + 2048 + v);
                    const f32x4 o = oacc[vt][tt] * rs * gn;
                    u32x2 yw; yw.x = cvt_pk_bf16(o[0] * siluf_(bflo(gt.x)), o[1] * siluf_(bfhi(gt.x))); yw.y = cvt_pk_bf16(o[2] * siluf_(bflo(gt.y)), o[3] * siluf_(bfhi(gt.y)));
                    *(u32x2*)(Y + (size_t)(tok0 + tl) * 1024 + v) = yw; } } }
    }
    __syncthreads();
}

constexpr int DK_ROW = 144;
constexpr int DA_OROW = 136, DA_OB = 0, DA_LSE = 256 * DA_OROW, DA_KS = DA_LSE + 1024, DA_NROWS = 384, DA_VS = DA_KS + DA_NROWS * DK_ROW;
static_assert(DA_VS + DA_NROWS * DK_ROW <= LDS_BYTES - 64, "dattn lds");
constexpr size_t OUT_OC = (size_t)NTOK * 512 * 4;
constexpr size_t OUT_LSEC = OUT_OC + (size_t)NTOK * 512 * 2;

__device__ __forceinline__ void da_task(const LAS uchar* ks0, const LAS uchar* vs0, int origin, int cl_lo, int cl_hi, int mq0, int Ls, float sd, const bf16x8 q0, const bf16x8 q1,
                                        int fr, int g, int q_, int p_, f32x4 (&oacc)[4], float& mx_out, float& ls_out) {
    float NEG_INF = -__builtin_inff(); asm volatile("" : "+v"(NEG_INF));
    bf16x8 kf[9][2];
#pragma unroll
    for (int it = 0; it < 9; ++it) { const int mk0 = mq0 - 64 + 16 * it; const int mkc = mk0 < cl_lo ? cl_lo : (mk0 > cl_hi ? cl_hi : mk0);
        const LAS uchar* kp = ks0 + (mkc - origin + fr) * DK_ROW + 16 * g; kf[it][0] = *(const LAS bf16x8*)kp; kf[it][1] = *(const LAS bf16x8*)(kp + 64); }
    f32x4 sc[9];
    float c1 = 0.125f * 1.44269504089f; asm volatile("" : "+v"(c1));
    const float sd2 = sd * 1.44269504089f, basef = (float)(4 * g - fr - 64);
#pragma unroll
    for (int it = 0; it < 9; ++it) { const int mk0 = mq0 - 64 + 16 * it; const bool valid = (mk0 >= 0) && (mk0 < Ls);
        f32x4 a = (f32x4){0.f, 0.f, 0.f, 0.f}; a = mfma16(kf[it][0], q0, a); a = mfma16(kf[it][1], q1, a);
#pragma unroll
        for (int rg = 0; rg < 4; ++rg) { const float relf = basef + (float)(16 * it + rg); float sv = a[rg] * c1 - sd2 * __builtin_fabsf(relf);
            if (it == 0) sv = (4 * g + rg >= fr) ? sv : NEG_INF;
            if (it == 8) sv = (4 * g + rg <= fr) ? sv : NEG_INF;
            a[rg] = valid ? sv : NEG_INF; }
        sc[it] = a; }
    __builtin_amdgcn_sched_barrier(0);
    s16x4 vlo[5][4], vhi[5][4];
#pragma unroll
    for (int pi = 0; pi < 5; ++pi) { const int ta = 2 * pi, tb = pi < 4 ? 2 * pi + 1 : 8;
        const int ma = mq0 - 64 + 16 * ta, mb = mq0 - 64 + 16 * tb;
        const int mca = ma < cl_lo ? cl_lo : (ma > cl_hi ? cl_hi : ma), mcb = mb < cl_lo ? cl_lo : (mb > cl_hi ? cl_hi : mb);
        const LAS uchar* va = vs0 + (mca - origin + 4 * g + q_) * DK_ROW + 8 * p_;
        const LAS uchar* vb = vs0 + (mcb - origin + 4 * g + q_) * DK_ROW + 8 * p_;
#pragma unroll
        for (int dt = 0; dt < 4; ++dt) { vlo[pi][dt] = tr_read(va + 32 * dt); vhi[pi][dt] = tr_read(vb + 32 * dt); } }
    __builtin_amdgcn_sched_barrier(0);
    float mx = NEG_INF;
#pragma unroll
    for (int it = 0; it < 9; ++it) mx = fmaxf(fmaxf(fmaxf(sc[it][0], sc[it][1]), fmaxf(sc[it][2], sc[it][3])), mx);
    mx = fmaxf(mx, __shfl_xor(mx, 16)); mx = fmaxf(mx, __shfl_xor(mx, 32));
    float ls = 0.f;
#pragma unroll
    for (int it = 0; it < 9; ++it)
#pragma unroll
        for (int rg = 0; rg < 4; ++rg) { const float e = __builtin_amdgcn_exp2f(sc[it][rg] - mx); sc[it][rg] = e; ls += e; }
    ls += __shfl_xor(ls, 16); ls += __shfl_xor(ls, 32);
#pragma unroll
    for (int dt = 0; dt < 4; ++dt) oacc[dt] = (f32x4){0.f, 0.f, 0.f, 0.f};
#pragma unroll
    for (int pi = 0; pi < 5; ++pi) {
        const bf16x8 pb = pack8(sc[2 * pi], pi < 4 ? sc[2 * pi + 1] : (f32x4){0.f, 0.f, 0.f, 0.f});
#pragma unroll
        for (int dt = 0; dt < 4; ++dt) oacc[dt] = mfma16(cat8(vlo[pi][dt], vhi[pi][dt]), pb, oacc[dt]);
    }
    mx_out = mx * 0.69314718056f; ls_out = ls;
}

__device__ void dattn16_unit(LAS uchar* lds, const Params& p, int unit, unsigned* done, int wb) {
    int tid = TIDX; asm volatile("" : "+v"(tid));
    const int lane = tid & 63, wid = __builtin_amdgcn_readfirstlane(tid >> 6);
    const int fr = lane & 15, g = lane >> 4, q_ = fr >> 2, p_ = fr & 3;
    const int b = unit >> 6, head = (unit >> 3) & 7, rp = unit & 7;
    const bf16_t* proj = (const bf16_t*)(p.ws + WS_BIG) + (size_t)b * SEQ * IN_COLS;
    bf16_t* OC = (bf16_t*)((uchar*)p.out + OUT_OC) + (size_t)b * SEQ * 512;
    float* LSEC = (float*)((uchar*)p.out + OUT_LSEC) + (size_t)b * SEQ * 8;
    constexpr int KS = 0, VS = 2 * 128 * DK_ROW;
    __syncthreads();
#pragma unroll
    for (int i = 0; i < 8; ++i) { const int c = tid + 512 * i, kv = c >> 11, cc = c & 2047, res = cc >> 10, m = (cc >> 3) & 127, ch = cc & 7;
        const unsigned so = (unsigned)((16 * m + 2 * rp + res) * IN_COLS + (kv ? 3584 : 3072) + head * 64 + ch * 8) * 2u;
        *(LAS u32x4*)(lds + (kv ? VS : KS) + (res * 128 + m) * DK_ROW + ch * 16) = *(const u32x4*)((const char*)proj + so); }
    __syncthreads();
    const float sd = __builtin_amdgcn_exp2f(-(float)(head + 1)) * 16.0f;
#pragma unroll 1
    for (int res = 0; res < 2; ++res) {
        const int r = 2 * rp + res, mq0 = 16 * wid, tok = 16 * (mq0 + fr) + r;
        bf16x8 q0, q1;
        { const unsigned qo = (unsigned)(tok * IN_COLS + 2560 + head * 64 + 8 * g) * 2u; q0 = *(const bf16x8*)((const char*)proj + qo); q1 = *(const bf16x8*)((const char*)proj + qo + 64); }
        f32x4 oacc[4]; float mx, ls;
        da_task(lds + KS + res * 128 * DK_ROW, lds + VS + res * 128 * DK_ROW, 0, 0, 112, mq0, 128, sd, q0, q1, fr, g, q_, p_, oacc, mx, ls);
        const float inv = fast_rcp(ls);
#pragma unroll
        for (int dt = 0; dt < 4; ++dt) { u32x2 w2; w2.x = cvt_pk_bf16(oacc[dt][0] * inv, oacc[dt][1] * inv); w2.y = cvt_pk_bf16(oacc[dt][2] * inv, oacc[dt][3] * inv);
            __hip_atomic_store((unsigned long long*)(OC + (size_t)tok * 512 + head * 64 + 16 * dt + 4 * g), ((unsigned long long)w2.y << 32) | w2.x, __ATOMIC_RELAXED, __HIP_MEMORY_SCOPE_AGENT); }
        if (g == 0) __hip_atomic_store(LSEC + (size_t)tok * 8 + head, mx + __logf(ls), __ATOMIC_RELAXED, __HIP_MEMORY_SCOPE_AGENT);
    }
    __syncthreads();
    if (tid == 0) __hip_atomic_fetch_add(done, 1u, __ATOMIC_RELAXED, __HIP_MEMORY_SCOPE_AGENT);
}

__device__ void dattn_unit(LAS uchar* lds, const Params& p, int unit, const unsigned* done, int& seen_done, int wb) {
    int tid = TIDX; asm volatile("" : "+v"(tid));
    const int lane = tid & 63, wid = __builtin_amdgcn_readfirstlane(tid >> 6);
    const int fr = lane & 15, g = lane >> 4, q_ = fr >> 2, p_ = fr & 3;
    const int b = unit >> 6, head = (unit >> 3) & 7, qb = unit & 7, t0 = qb * 256;
    const bf16_t* proj = (const bf16_t*)(p.ws + WS_BIG) + (size_t)b * SEQ * IN_COLS;
    bf16_t* Y = (bf16_t*)(p.ws + WS_Y) + (size_t)b * SEQ * 1024;
    const float slope = __builtin_amdgcn_exp2f(-(float)(head + 1));
    u32x4 sreg[12];
#define DA_LOAD1(i0, i1) do { _Pragma("unroll") for (int i = (i0); i < (i1); ++i) { const int c = tid + 512 * i, kv = c >= 3072 ? 1 : 0, cc = c - kv * 3072, row = cc >> 3, ch = cc & 7; \
        int tok = t0 - 64 + row; tok = tok < 0 ? 0 : (tok > SEQ - 1 ? SEQ - 1 : tok); \
        sreg[i] = *(const u32x4*)((const char*)proj + (unsigned)(tok * IN_COLS + (kv ? 3584 : 3072) + head * 64 + ch * 8) * 2u); } } while (0)
#define DA_LOAD4(h, i0, i1) do { int tl_ = tid; asm volatile("" : "+v"(tl_)); _Pragma("unroll") for (int i = (i0); i < (i1); ++i) { const int c = tl_ + 512 * i, kv = c >= 3072 ? 1 : 0, cc = c - kv * 3072, rowi = cc >> 3, ch = cc & 7, res = rowi >= 192 ? 1 : 0, mrow = rowi - res * 192; \
        int m = (t0 >> 2) - 64 + mrow; m = m < 0 ? 0 : (m > 511 ? 511 : m); \
        sreg[i] = *(const u32x4*)((const char*)proj + (unsigned)((4 * m + 2 * (h) + res) * IN_COLS + (kv ? 3584 : 3072) + head * 64 + ch * 8) * 2u); } } while (0)
#define DA_WRITE() do { int tw_ = tid; asm volatile("" : "+v"(tw_)); _Pragma("unroll") for (int i = 0; i < 12; ++i) { const int c = tw_ + 512 * i, kv = c >= 3072 ? 1 : 0, cc = c - kv * 3072, rowi = cc >> 3, ch = cc & 7; \
        *(LAS u32x4*)(lds + (kv ? DA_VS : DA_KS) + rowi * DK_ROW + ch * 16) = sreg[i]; } } while (0)
    constexpr int DA_PF = 10;
    DA_LOAD1(0, 12);
    __syncthreads();
    DA_WRITE();
    __syncthreads();
    DA_LOAD4(0, 0, DA_PF);
#pragma unroll 1
    for (int t = 0; t < 2; ++t) { const int j = 2 * wid + t, mq0 = t0 + 16 * j, tok = mq0 + fr;
        bf16x8 q0, q1;
        { const unsigned qo = (unsigned)(tok * IN_COLS + 2560 + head * 64 + 8 * g) * 2u; q0 = *(const bf16x8*)((const char*)proj + qo); q1 = *(const bf16x8*)((const char*)proj + qo + 64); }
        f32x4 oacc[4]; float mx, ls;
        da_task(lds + DA_KS, lds + DA_VS, t0 - 64, t0 - 64, t0 + 304, mq0, SEQ, slope, q0, q1, fr, g, q_, p_, oacc, mx, ls);
        const float inv = fast_rcp(ls); const int tl = 16 * j + fr;
#pragma unroll
        for (int dt = 0; dt < 4; ++dt) { u32x2 w2; w2.x = cvt_pk_bf16(oacc[dt][0] * inv, oacc[dt][1] * inv); w2.y = cvt_pk_bf16(oacc[dt][2] * inv, oacc[dt][3] * inv);
            *(LAS u32x2*)(lds + DA_OB + tl * DA_OROW + (16 * dt + 4 * g) * 2) = w2; }
        if (g == 0) *(LAS float*)(lds + DA_LSE + tl * 4) = mx + __logf(ls);
    }
#pragma unroll
    for (int h = 0; h < 2; ++h) {
        DA_LOAD4(h, DA_PF, 12);
        __syncthreads();
        DA_WRITE();
        __syncthreads();
        if (h == 0) { DA_LOAD4(1, 0, DA_PF); }
        const int mbase = t0 >> 2;
        const int res = wid >> 2, jj = wid & 3, r = 2 * h + res, mq0 = mbase + 16 * jj, tok = 4 * (mq0 + fr) + r;
        bf16x8 q0, q1;
        { const unsigned qo = (unsigned)(tok * IN_COLS + 2560 + head * 64 + 8 * g) * 2u; q0 = *(const bf16x8*)((const char*)proj + qo); q1 = *(const bf16x8*)((const char*)proj + qo + 64); }
        f32x4 oacc[4]; float mx, ls;
        da_task(lds + DA_KS + res * 192 * DK_ROW, lds + DA_VS + res * 192 * DK_ROW, mbase - 64, mbase - 64, mbase + 112, mq0, 512, slope * 4.0f, q0, q1, fr, g, q_, p_, oacc, mx, ls);
        const int tl = tok - t0;
        const float lse_c = mx + __logf(ls), lse_p = *(const LAS float*)(lds + DA_LSE + tl * 4);
        const float Lm = fmaxf(lse_c, lse_p), wc0 = fast_exp(lse_c - Lm), wp0 = fast_exp(lse_p - Lm), winv = fast_rcp(wc0 + wp0), wc = wc0 * winv * fast_rcp(ls), wp = wp0 * winv;
#pragma unroll
        for (int dt = 0; dt < 4; ++dt) { LAS u32x2* op = (LAS u32x2*)(lds + DA_OB + tl * DA_OROW + (16 * dt + 4 * g) * 2); const u32x2 pv = *op;
            u32x2 w2; w2.x = cvt_pk_bf16(wp * bflo(pv.x) + wc * oacc[dt][0], wp * bfhi(pv.x) + wc * oacc[dt][1]); w2.y = cvt_pk_bf16(wp * bflo(pv.y) + wc * oacc[dt][2], wp * bfhi(pv.y) + wc * oacc[dt][3]); *op = w2; }
        if (g == 0) *(LAS float*)(lds + DA_LSE + tl * 4) = Lm + __logf(wc0 + wp0);
    }
#undef DA_LOAD1
#undef DA_LOAD4
#undef DA_WRITE
    if (!seen_done) {
        if (tid == 0) { while (__hip_atomic_load(done, __ATOMIC_RELAXED, __HIP_MEMORY_SCOPE_AGENT) < 2048u) __builtin_amdgcn_s_sleep(8); __builtin_amdgcn_fence(__ATOMIC_ACQUIRE, "agent"); }
        seen_done = 1;
    }
    __syncthreads();
    { const int tl = tid >> 1, hf = tid & 1;
      const bf16_t* OC = (const bf16_t*)((const uchar*)p.out + OUT_OC) + ((size_t)b * SEQ + t0 + tl) * 512 + head * 64 + hf * 32;
      const float* LSEC = (const float*)((const uchar*)p.out + OUT_LSEC) + ((size_t)b * SEQ + t0 + tl) * 8 + head;
      const float l0 = *(const LAS float*)(lds + DA_LSE + tl * 4), l2 = __builtin_nontemporal_load(LSEC);
      const float M = fmaxf(l0, l2); float w0 = fast_exp(l0 - M), w2 = fast_exp(l2 - M); const float inv = fast_rcp(w0 + w2); w0 *= inv; w2 *= inv;
      bf16_t* yp = Y + (size_t)(t0 + tl) * 1024 + 512 + head * 64 + hf * 32;
#pragma unroll
      for (int c = 0; c < 4; ++c) { const u32x4 cv = __builtin_nontemporal_load((const u32x4*)(OC + 8 * c)); f32x4 o[2];
          const u32x2 a0 = *(const LAS u32x2*)(lds + DA_OB + tl * DA_OROW + (hf * 32 + 8 * c) * 2), a1 = *(const LAS u32x2*)(lds + DA_OB + tl * DA_OROW + (hf * 32 + 8 * c + 4) * 2);
          o[0][0] = w0 * bflo(a0.x) + w2 * bflo(cv.x); o[0][1] = w0 * bfhi(a0.x) + w2 * bfhi(cv.x); o[0][2] = w0 * bflo(a0.y) + w2 * bflo(cv.y); o[0][3] = w0 * bfhi(a0.y) + w2 * bfhi(cv.y);
          o[1][0] = w0 * bflo(a1.x) + w2 * bflo(cv.z); o[1][1] = w0 * bfhi(a1.x) + w2 * bfhi(cv.z); o[1][2] = w0 * bflo(a1.y) + w2 * bflo(cv.w); o[1][3] = w0 * bfhi(a1.y) + w2 * bfhi(cv.w);
          *(bf16x8*)(yp + 8 * c) = pack8(o[0], o[1]); } }
    __syncthreads();
}

constexpr int XA_KROW = 528;
static_assert(256 * XA_KROW <= LDS_BYTES - 64, "xattn lds");
__device__ __forceinline__ void xa_stage(LAS uchar* lds, const char* src, int pitch, int tid0) {
    int t = tid0; asm volatile("" : "+v"(t));
#pragma unroll
    for (int hb = 0; hb < 2; ++hb) { u32x4 r[8];
#pragma unroll
        for (int i = 0; i < 8; ++i) { const int c = t + 512 * (8 * hb + i), row = c >> 5, c16 = c & 31; r[i] = *(const u32x4*)(src + (unsigned)(row * pitch + c16 * 16)); }
#pragma unroll
        for (int i = 0; i < 8; ++i) { const int c = t + 512 * (8 * hb + i), row = c >> 5, c16 = c & 31; *(LAS u32x4*)(lds + row * XA_KROW + c16 * 16) = r[i]; } }
}
__device__ void xattn_wg(LAS uchar* lds, const Params& p, int layer, int su, int wb) {
    int tid = TIDX; asm volatile("" : "+v"(tid));
    const int lane = tid & 63, wid = __builtin_amdgcn_readfirstlane(tid >> 6);
    const int fr = lane & 15, g = lane >> 4;
    const int xj = su >> 3, b = 4 * (su & 7) + (xj >> 3), hx = (xj >> 1) & 3, half = xj & 1;
    const bf16_t* KX = (const bf16_t*)(p.ws + WS_KX) + ((size_t)layer * 8192 + (size_t)b * 256) * 1024 + hx * 256;
    const bf16_t* VT = (const bf16_t*)(p.ws + WS_VXT) + ((size_t)layer * 32 + b) * 1024 * 256 + (size_t)hx * 256 * 256;
    __syncthreads();
    xa_stage(lds, (const char*)KX, 2048, tid);
    __syncthreads();
    const LAS uchar* kbase = lds + fr * XA_KROW + 16 * g;
#pragma unroll 1
    for (int blk = 0; blk < 4; ++blk) {
        const int qb = half * 4 + blk;
        const bf16_t* qx = (const bf16_t*)(p.ws + WS_BIG) + ((size_t)b * SEQ + qb * 256 + wid * 32) * 1024 + hx * 256;
        bf16_t* OX = (bf16_t*)(p.ws + WS_Y) + ((size_t)b * SEQ + qb * 256 + wid * 32) * 1024 + hx * 256;
        f32x4 acc[2][16];
#pragma unroll
        for (int qt = 0; qt < 2; ++qt)
#pragma unroll
            for (int kt = 0; kt < 16; ++kt) acc[qt][kt] = (f32x4){0.f, 0.f, 0.f, 0.f};
#pragma unroll
        for (int kh = 0; kh < 2; ++kh) {
            bf16x8 qf[2][4];
#pragma unroll
            for (int qt = 0; qt < 2; ++qt)
#pragma unroll
                for (int ks = 0; ks < 4; ++ks) qf[qt][ks] = *(const bf16x8*)((const char*)qx + (unsigned)((16 * qt + fr) * 1024 + 32 * (4 * kh + ks) + 8 * g) * 2u);
            bf16x8 kfa[4], kfb[4];
#define XA_KLOAD(dst, kt) do { const LAS uchar* _kp = kbase + (kt) * 16 * XA_KROW; asm volatile("" : "+v"(_kp)); _Pragma("unroll") for (int ks = 0; ks < 4; ++ks) dst[ks] = *(const LAS bf16x8*)(_kp + (32 * (4 * kh + ks)) * 2); } while (0)
#define XA_KMMA(src, kt) do { __builtin_amdgcn_s_setprio(1); _Pragma("unroll") for (int ks = 0; ks < 4; ++ks) { acc[0][kt] = mfma16(src[ks], qf[0][ks], acc[0][kt]); acc[1][kt] = mfma16(src[ks], qf[1][ks], acc[1][kt]); } __builtin_amdgcn_s_setprio(0); } while (0)
            XA_KLOAD(kfa, 0);
#pragma unroll
            for (int kt = 0; kt < 16; kt += 2) {
                XA_KLOAD(kfb, kt + 1); __builtin_amdgcn_sched_barrier(0);
                XA_KMMA(kfa, kt); __builtin_amdgcn_sched_barrier(0);
                if (kt + 2 < 16) { XA_KLOAD(kfa, kt + 2); } __builtin_amdgcn_sched_barrier(0);
                XA_KMMA(kfb, kt + 1); __builtin_amdgcn_sched_barrier(0);
            }
#undef XA_KLOAD
#undef XA_KMMA
        }
        float inv[2];
        bf16x8 pk[2][8];
#pragma unroll
        for (int qt = 0; qt < 2; ++qt) { float mx = -__builtin_inff();
#pragma unroll
            for (int kt = 0; kt < 16; ++kt) mx = fmaxf(fmaxf(fmaxf(acc[qt][kt][0], acc[qt][kt][1]), fmaxf(acc[qt][kt][2], acc[qt][kt][3])), mx);
            mx = fmaxf(mx, __shfl_xor(mx, 16)); mx = fmaxf(mx, __shfl_xor(mx, 32));
            float ls = 0.f;
#pragma unroll
            for (int kt = 0; kt < 16; ++kt)
#pragma unroll
                for (int rg = 0; rg < 4; ++rg) { const float e = __builtin_amdgcn_exp2f(acc[qt][kt][rg] - mx); acc[qt][kt][rg] = e; ls += e; }
            ls += __shfl_xor(ls, 16); ls += __shfl_xor(ls, 32); inv[qt] = fast_rcp(ls);
#pragma unroll
            for (int ks = 0; ks < 8; ++ks) pk[qt][ks] = pack8(acc[qt][2 * ks], acc[qt][2 * ks + 1]); }
        __syncthreads();
        xa_stage(lds, (const char*)VT, 512, tid);
        __syncthreads();
#pragma unroll
        for (int dt = 0; dt < 16; ++dt) {
            bf16x8 vf[8];
            { const LAS uchar* _vb = kbase; asm volatile("" : "+v"(_vb)); const LAS uchar* _vp = _vb + dt * 16 * XA_KROW;
#pragma unroll
              for (int ks = 0; ks < 8; ++ks) vf[ks] = *(const LAS bf16x8*)(_vp + 64 * ks); }
            f32x4 o0 = (f32x4){0.f, 0.f, 0.f, 0.f}, o1 = (f32x4){0.f, 0.f, 0.f, 0.f};
            __builtin_amdgcn_s_setprio(1);
#pragma unroll
            for (int ks = 0; ks < 8; ++ks) { o0 = mfma16(vf[ks], pk[0][ks], o0); o1 = mfma16(vf[ks], pk[1][ks], o1); }
            __builtin_amdgcn_s_setprio(0);
            u32x2 w0; w0.x = cvt_pk_bf16(o0[0] * inv[0], o0[1] * inv[0]); w0.y = cvt_pk_bf16(o0[2] * inv[0], o0[3] * inv[0]);
            u32x2 w1; w1.x = cvt_pk_bf16(o1[0] * inv[1], o1[1] * inv[1]); w1.y = cvt_pk_bf16(o1[2] * inv[1], o1[3] * inv[1]);
            unsigned oo = (unsigned)(fr * 1024 + 16 * dt + 4 * g) * 2u; asm volatile("" : "+v"(oo));
            *(u32x2*)((char*)OX + oo) = w0; *(u32x2*)((char*)OX + oo + 16 * 1024 * 2) = w1; }
        if (blk < 3) { __syncthreads(); xa_stage(lds, (const char*)KX, 2048, tid); __syncthreads(); }
    }
    __syncthreads();
}

#define XB_TMO      128
#define XB_XCNT(j)  (256  + 64 * (j))
#define XB_XSUB(j)  (1280 + 64 * (j))
#define XB_XGEN(j)  (2304 + 64 * (j))
#define XB_TOP      3328
#define XB_TOPGEN   3392
#define XCD_BAR_WORDS 3456
#define XB_SPIN_CAP (1u << 22)
__device__ __forceinline__ unsigned xb_ld(unsigned* p)              { return __hip_atomic_load(p, __ATOMIC_RELAXED, __HIP_MEMORY_SCOPE_AGENT); }
__device__ __forceinline__ unsigned xb_add(unsigned* p, unsigned v) { return __hip_atomic_fetch_add(p, v, __ATOMIC_RELAXED, __HIP_MEMORY_SCOPE_AGENT); }
__device__ __forceinline__ unsigned xb_xcc_id() { return (unsigned)__builtin_amdgcn_s_getreg((3 << 11) | 20) & 0xFu; }
#define XB_SPIN(cond, bar) do { unsigned _sp = 0; while (cond) { __builtin_amdgcn_s_sleep(1); \
    if ((++_sp & 255u) == 0u) { if (xb_ld(&(bar)[XB_TMO])) break; if (_sp > XB_SPIN_CAP) { atomicAdd(&(bar)[XB_TMO], 1u); break; } } } } while (0)
struct XcdBarrier { unsigned* bar; unsigned x; volatile LAS unsigned* st; };
__device__ __forceinline__ XcdBarrier xcd_barrier_post(unsigned* bar, volatile LAS unsigned* st, int wb) {
    XcdBarrier b; b.bar = bar; b.x = xb_xcc_id(); b.st = st;
    if (TIDX == 0) (void)xb_add(&bar[XB_XCNT(b.x)], 1u);
    return b;
}
__device__ __forceinline__ void xcd_barrier_complete(unsigned* bar, unsigned x, unsigned& nloc, unsigned& nx) {
    const unsigned G = gridDim.x * gridDim.y * gridDim.z;
    unsigned sum, cnt, mine, sp = 0u;
    for (;;) {
        sum = 0u; cnt = 0u; mine = 0u;
#pragma unroll
        for (unsigned j = 0; j < 16; ++j) { const unsigned c = xb_ld(&bar[XB_XCNT(j)]); sum += c; cnt += (c > 0u) ? 1u : 0u; mine = (j == x) ? c : mine; }
        if (sum == G) break;
        __builtin_amdgcn_s_sleep(1);
        if ((++sp & 255u) == 0u) { if (xb_ld(&bar[XB_TMO])) break; if (sp > XB_SPIN_CAP) { atomicAdd(&bar[XB_TMO], 1u); break; } }
    }
    nloc = mine > 0u ? mine : 1u; nx = cnt > 0u ? cnt : 1u;
}
__device__ __forceinline__ void xcd_barrier(const XcdBarrier& b, int wb) {
    asm volatile("s_waitcnt vmcnt(0)" ::: "memory");
    __syncthreads();
    if (TIDX == 0) {
        unsigned* bar = b.bar;
        __builtin_amdgcn_s_waitcnt(0);
        unsigned nloc = b.st[0], nx = b.st[1];
        if (nloc == 0u) { xcd_barrier_complete(bar, b.x, nloc, nx); b.st[0] = nloc; b.st[1] = nx; }
        const unsigned old = xb_add(&bar[XB_XSUB(b.x)], 1u);
        const unsigned gen = old / nloc;
        if (old + 1u == (gen + 1u) * nloc) {
            __builtin_amdgcn_fence(__ATOMIC_RELEASE, "agent");
            asm volatile("s_waitcnt vmcnt(0)" ::: "memory");
            const unsigned og = xb_add(&bar[XB_TOP], 1u);
            const unsigned tg = og / nx;
            if (og + 1u == (tg + 1u) * nx) xb_add(&bar[XB_TOPGEN], 1u);
            else XB_SPIN(xb_ld(&bar[XB_TOPGEN]) == tg, bar);
            __builtin_amdgcn_fence(__ATOMIC_ACQUIRE, "agent");
            xb_add(&bar[XB_XGEN(b.x)], 1u);
            asm volatile("s_waitcnt vmcnt(0)" ::: "memory");
        } else {
            XB_SPIN(xb_ld(&bar[XB_XGEN(b.x)]) == gen, bar);
            __builtin_amdgcn_fence(__ATOMIC_ACQUIRE, "agent");
            asm volatile("s_waitcnt vmcnt(0)" ::: "memory");
        }
    }
    __syncthreads();
}

#if PROBE_WHICH
#define TS_BEGIN(id) do { if ((id) == PROBE_WHICH) ts0 = __builtin_amdgcn_s_memrealtime(); } while (0)
#define TS_END(id) do { if ((id) == PROBE_WHICH) tacc += __builtin_amdgcn_s_memrealtime() - ts0; } while (0)
#else
#define TS_BEGIN(id) do {} while (0)
#define TS_END(id) do {} while (0)
#endif
__global__ void __launch_bounds__(512) fwd_megakernel(Params p) {
    extern __shared__ __attribute__((aligned(16))) uchar lds_raw[];
    LAS uchar* lds = (LAS uchar*)lds_raw;
    cg::grid_group grid = cg::this_grid();
    const int wb = __builtin_amdgcn_readfirstlane((int)threadIdx.x) & ~63;
    volatile LAS unsigned* xst = (volatile LAS unsigned*)(lds + LDS_BYTES - 32);
    if (TIDX == 0) { xst[0] = 0u; xst[1] = 0u; }
    __syncthreads();
    const int tid = TIDX, G = gridDim.x;
    uchar* ws = p.ws;
#if PROBE_WHICH
    unsigned long long ts0 = 0, tacc = 0;
#endif
    bf16_t* HB = (bf16_t*)(ws + WS_HB); bf16_t* BIG = (bf16_t*)(ws + WS_BIG); bf16_t* YB = (bf16_t*)(ws + WS_Y); bf16_t* MEMB = (bf16_t*)(ws + WS_MEMB);
    bf16_t* WB = (bf16_t*)(ws + WS_W); float* ROWSS = (float*)(ws + WS_ROWSS); float* MEMSS = (float*)(ws + WS_MEMSS); unsigned* CTR = (unsigned*)(ws + WS_CTR);

    TS_BEGIN(1);
    {
        int base = 0;
        for (int l = 0; l < 2; ++l) { bf16_t* W = WB + (size_t)l * W_LAYER;
            convert_weight(lds, p.w1g + (size_t)l * 1024 * 2816, 1024, 2816, W + W_GU1, 256, 0, p.ln_ffn1 + l * 1024, base, wb);
            convert_weight(lds, p.w1u + (size_t)l * 1024 * 2816, 1024, 2816, W + W_GU1, 256, 128, p.ln_ffn1 + l * 1024, base, wb);
            convert_weight(lds, p.w1d + (size_t)l * 2816 * 1024, 2816, 1024, W + W_D1, 128, 0, nullptr, base, wb);
            convert_weight(lds, p.w_in + (size_t)l * 1024 * 4096, 1024, 4096, W + W_IN, 128, 0, p.ln_mix + l * 1024, base, wb);
            convert_weight(lds, p.w_out + (size_t)l * 1024 * 1024, 1024, 1024, W + W_OUT, 128, 0, nullptr, base, wb);
            convert_weight(lds, p.w_xq + (size_t)l * 1024 * 1024, 1024, 1024, W + W_XQ, 128, 0, p.ln_xq + l * 1024, base, wb);
            convert_weight(lds, p.w_xkv + (size_t)l * 1024 * 2048, 1024, 2048, W + W_XKV, 128, 0, p.ln_mem + l * 1024, base, wb);
            convert_weight(lds, p.w_xo + (size_t)l * 1024 * 1024, 1024, 1024, W + W_XO, 128, 0, nullptr, base, wb);
            convert_weight(lds, p.w2g + (size_t)l * 1024 * 2816, 1024, 2816, W + W_GU2, 256, 0, p.ln_ffn2 + l * 1024, base, wb);
            convert_weight(lds, p.w2u + (size_t)l * 1024 * 2816, 1024, 2816, W + W_GU2, 256, 128, p.ln_ffn2 + l * 1024, base, wb);
            convert_weight(lds, p.w2d + (size_t)l * 2816 * 1024, 2816, 1024, W + W_D2, 128, 0, nullptr, base, wb); }
        convert_rows(p.x, HB, ROWSS, NTOK, wb);
        convert_rows(p.mem, MEMB, MEMSS, 8192, wb);
        if (blockIdx.x == 0 && tid < 64) CTR[tid] = 0u;
        if (blockIdx.x == 0) { unsigned* bw = (unsigned*)(p.ws + WS_BAR); for (int i = tid; i < 3456; i += 512) bw[i] = 0u; }
    }
    grid.sync();
    const XcdBarrier xbar = xcd_barrier_post((unsigned*)(p.ws + WS_BAR), xst, wb);
    TS_END(1);
    pg8::StaticOrder S;
    TS_BEGIN(2);
    for (int l = 0; l < 2; ++l) { S.init(8192, 2048, G, blockIdx.x);
        pg8::EpiMemKV E{(bf16_t*)(ws + WS_KX) + (size_t)l * 8192 * 1024, (bf16_t*)(ws + WS_VXT) + (size_t)l * 8192 * 1024, MEMSS};
        pg8::gemm_phase(lds, pg8::Gemm{MEMB, WB + (size_t)l * W_LAYER + W_XKV, 8192, 2048, 1024}, S, E, wb); }
    TS_END(2);

    for (int l = 0; l < 2; ++l) {
        const Params& pl = p;
        const bf16_t* W = WB + (size_t)l * W_LAYER;
        TS_BEGIN(3);
        { S.init(NTOK, 5632, G, blockIdx.x); pg8::EpiSwiglu E{BIG, ROWSS + (size_t)(4 * l + 0) * NTOK * 16};
          pg8::gemm_phase(lds, pg8::Gemm{HB, W + W_GU1, NTOK, 5632, 1024}, S, E, wb); }
        xcd_barrier(xbar, wb);
        TS_END(3); TS_BEGIN(4);
        { S.init(NTOK, 1024, G, blockIdx.x); pg8::EpiRes E{HB, ROWSS + (size_t)(4 * l + 1) * NTOK * 16, 0.5f};
          pg8::gemm_phase(lds, pg8::Gemm{BIG, W + W_D1, NTOK, 1024, 2816}, S, E, wb); }
        xcd_barrier(xbar, wb);
        TS_END(4); TS_BEGIN(5);
        { S.init(NTOK, 4096, G, blockIdx.x); pg8::EpiScale E{BIG, 4096, ROWSS + (size_t)(4 * l + 1) * NTOK * 16, 1.0f};
          pg8::gemm_phase(lds, pg8::Gemm{HB, W + W_IN, NTOK, 4096, 1024}, S, E, wb); }
        xcd_barrier(xbar, wb);
        TS_END(5); TS_BEGIN(6);
        {
#ifndef NO_HGRN
          TS_BEGIN(9);
          for (int u = blockIdx.x; u < 128; u += G) hgrn_unit(lds, pl, l, u, wb);
          TS_END(9);
#endif
          volatile LAS unsigned* bc = (volatile LAS unsigned*)(lds + LDS_BYTES - 16);
          int qtid = TIDX; asm volatile("" : "+v"(qtid));
          int seen_done = 0;
          TS_BEGIN(10);
          for (;;) { if (qtid == 0) *bc = atomicAdd(CTR + l, 1u); __syncthreads(); const unsigned u = *bc; __syncthreads(); if (u >= 4096u) break;
#ifndef NO_DATT
            if (u < 2048u) { TS_BEGIN(11); dattn16_unit(lds, pl, (int)u, CTR + 8 + l, wb); TS_END(11); } else { const int sd0 = seen_done; if (sd0) TS_BEGIN(12); dattn_unit(lds, pl, (int)u - 2048, CTR + 8 + l, seen_done, wb); if (sd0) TS_END(12); if (!sd0) TS_END(10); }
#endif
          } }
        xcd_barrier(xbar, wb);
        TS_END(6); TS_BEGIN(7);
        { S.init(NTOK, 1024, G, blockIdx.x); pg8::EpiRes E{HB, ROWSS + (size_t)(4 * l + 2) * NTOK * 16, 1.0f};
          pg8::gemm_phase(lds, pg8::Gemm{YB, W + W_OUT, NTOK, 1024, 1024}, S, E, wb); }
        xcd_barrier(xbar, wb);
#ifndef NO_XATT
        for (int u = blockIdx.x; u < 256; u += G) {
            const int xj = u >> 3, xb = 4 * (u & 7) + (xj >> 3), xh = (xj >> 1) & 3, half = xj & 1;
            pg8::XqOrder XS{8 * xb + 4 * half, xh}; pg8::EpiScale E{BIG, 1024, ROWSS + (size_t)(4 * l + 2) * NTOK * 16, 0.0625f * 1.44269504089f};
            pg8::gemm_phase(lds, pg8::Gemm{HB, W + W_XQ, NTOK, 1024, 1024}, XS, E, wb);
            xattn_wg(lds, pl, l, u, wb); }
#endif
        xcd_barrier(xbar, wb);
        TS_END(8); TS_BEGIN(7);
        { S.init(NTOK, 1024, G, blockIdx.x); pg8::EpiRes E{HB, ROWSS + (size_t)(4 * l + 3) * NTOK * 16, 1.0f};
          pg8::gemm_phase(lds, pg8::Gemm{YB, W + W_XO, NTOK, 1024, 1024}, S, E, wb); }
        xcd_barrier(xbar, wb);
        TS_END(7); TS_BEGIN(3);
        { S.init(NTOK, 5632, G, blockIdx.x); pg8::EpiSwiglu E{BIG, ROWSS + (size_t)(4 * l + 3) * NTOK * 16};
          pg8::gemm_phase(lds, pg8::Gemm{HB, W + W_GU2, NTOK, 5632, 1024}, S, E, wb); }
        xcd_barrier(xbar, wb);
        TS_END(3); TS_BEGIN(4);
        { S.init(NTOK, 1024, G, blockIdx.x); pg8::EpiRes E{HB, ROWSS + (size_t)(4 * l + 4) * NTOK * 16, 0.5f};
          pg8::gemm_phase(lds, pg8::Gemm{BIG, W + W_D2, NTOK, 1024, 2816}, S, E, wb); }
#if PROBE_WHICH
        if (l == 1) { TS_END(4); if (blockIdx.x == (PROBE_WHICH >= 10 ? G - 1 : 0) && tid == 0) { CTR[32] = (unsigned)(tacc / 10ull); __threadfence(); } }
#endif
        xcd_barrier(xbar, wb);
#if PROBE_WHICH
        if (l == 0) TS_END(4);
#endif
    }
#if PROBE_WHICH
    final_norm(p.out, HB, ROWSS + (size_t)8 * NTOK * 16, p.ln_final, (size_t)CTR[32], wb);
#else
    final_norm(p.out, HB, ROWSS + (size_t)8 * NTOK * 16, p.ln_final, 0, wb);
#endif
}

extern "C" void kernel_launch(void* const* d_in, const int* in_sizes, int n_in, void* d_out, int out_size, void* d_ws, size_t ws_size, hipStream_t stream) {
    static int grid_blocks = 0;
    if (!grid_blocks) {
        int dev = 0, cus = 0, per_cu = 0;
        hipGetDevice(&dev);
        hipDeviceGetAttribute(&cus, hipDeviceAttributeMultiprocessorCount, dev);
        if (hipFuncSetAttribute((const void*)fwd_megakernel, hipFuncAttributeMaxDynamicSharedMemorySize, LDS_BYTES) != hipSuccess) fprintf(stderr, "hipFuncSetAttribute failed\n");
        hipOccupancyMaxActiveBlocksPerMultiprocessor(&per_cu, (const void*)fwd_megakernel, 512, LDS_BYTES);
        if (per_cu < 1) per_cu = 1;
        grid_blocks = cus * per_cu;
        if (ws_size < WS_END) fprintf(stderr, "workspace too small: %zu < %zu\n", ws_size, (size_t)WS_END);
    }
    Params p{};
    const float** pp = (const float**)&p;
    for (int i = 0; i < 21; ++i) pp[i] = (const float*)d_in[i];
    p.out = (float*)d_out; p.ws = (uchar*)d_ws;
    void* args[] = {&p};
    hipError_t e = hipLaunchCooperativeKernel((const void*)fwd_megakernel, dim3(grid_blocks), dim3(512), args, LDS_BYTES, stream);
    if (e != hipSuccess) fprintf(stderr, "cooperative launch failed: %s (grid %d)\n", hipGetErrorString(e), grid_blocks);
}
```

```cpp
#ifndef PROBE_WHICH
#define PROBE_WHICH 0
#endif
#include <hip/hip_runtime.h>
#include <hip/hip_cooperative_groups.h>
#include <cstdio>
namespace cg = cooperative_groups;

#define LAS __attribute__((address_space(3)))
typedef unsigned short bf16_t;
typedef short bf16x8 __attribute__((ext_vector_type(8)));
typedef short s16x4 __attribute__((ext_vector_type(4)));
typedef float f32x4 __attribute__((ext_vector_type(4)));
typedef unsigned u32x4 __attribute__((ext_vector_type(4)));
typedef unsigned u32x2 __attribute__((ext_vector_type(2)));
typedef unsigned char uchar;

constexpr int D_MODEL = 1024, BATCH = 32, SEQ = 2048, NTOK = BATCH * SEQ, N_MEM = 256, D_FF = 2816, IN_COLS = 4096;
constexpr float EPS = 1e-6f;
constexpr int LDS_BYTES = 147456;

constexpr size_t WS_HB   = 0;
constexpr size_t WS_BIG  = WS_HB + (size_t)NTOK * 1024 * 2;
constexpr size_t WS_Y    = WS_BIG + (size_t)NTOK * 4096 * 2;
constexpr size_t WS_MEMB = WS_Y + (size_t)NTOK * 1024 * 2;
constexpr size_t WS_KX   = WS_MEMB + (size_t)8192 * 1024 * 2;
constexpr size_t WS_VXT  = WS_KX + (size_t)2 * 8192 * 1024 * 2;
constexpr size_t WS_W    = WS_VXT + (size_t)2 * 8192 * 1024 * 2;
constexpr size_t W_GU1 = 0, W_D1 = W_GU1 + (size_t)5632 * 1024, W_IN = W_D1 + (size_t)1024 * 2816, W_OUT = W_IN + (size_t)4096 * 1024,
                 W_XQ = W_OUT + (size_t)1024 * 1024, W_XKV = W_XQ + (size_t)1024 * 1024, W_XO = W_XKV + (size_t)2048 * 1024,
                 W_GU2 = W_XO + (size_t)1024 * 1024, W_D2 = W_GU2 + (size_t)5632 * 1024, W_LAYER = W_D2 + (size_t)1024 * 2816;
constexpr size_t WS_ROWSS = WS_W + 2 * W_LAYER * 2;
constexpr size_t WS_MEMSS = WS_ROWSS + (size_t)9 * NTOK * 16 * 4;
constexpr size_t WS_CTR   = WS_MEMSS + (size_t)8192 * 16 * 4;
constexpr size_t WS_BAR   = WS_CTR + 256;
constexpr size_t WS_END   = WS_BAR + 3456 * 4;

struct Params {
    const float *x, *mem, *ln_ffn1, *w1g, *w1u, *w1d, *ln_mix, *w_in, *lb_logits, *hgrn_gain, *w_out, *ln_xq, *ln_mem, *w_xq, *w_xkv, *w_xo, *ln_ffn2, *w2g, *w2u, *w2d, *ln_final;
    float* out; uchar* ws;
};

typedef __bf16 bf16x2_native __attribute__((ext_vector_type(2)));
typedef float f32x2_native __attribute__((ext_vector_type(2)));
__device__ __forceinline__ unsigned cvt_pk_bf16(float lo, float hi) { const f32x2_native v = {lo, hi}; return __builtin_bit_cast(unsigned, __builtin_convertvector(v, bf16x2_native)); }
__device__ __forceinline__ float bf2f(unsigned short b) { return __uint_as_float(((unsigned)b) << 16); }
__device__ __forceinline__ float bflo(unsigned u) { return __uint_as_float(u << 16); }
__device__ __forceinline__ float bfhi(unsigned u) { return __uint_as_float(u & 0xffff0000u); }
__device__ __forceinline__ float fast_rcp(float x) { return __builtin_amdgcn_rcpf(x); }
__device__ __forceinline__ float fast_exp(float x) { return __builtin_amdgcn_exp2f(x * 1.44269504089f); }
__device__ __forceinline__ float sigmoidf_(float x) { return fast_rcp(1.0f + fast_exp(-x)); }
__device__ __forceinline__ float siluf_(float x) { return x * sigmoidf_(x); }
__device__ __forceinline__ s16x4 tr_read(const LAS uchar* p) { typedef short v4i16_t __attribute__((ext_vector_type(4)));
    return __builtin_bit_cast(s16x4, __builtin_amdgcn_ds_read_tr16_b64_v4i16((LAS v4i16_t*)p)); }
__device__ __forceinline__ bf16x8 cat8(s16x4 lo, s16x4 hi) { bf16x8 r; r[0] = lo[0]; r[1] = lo[1]; r[2] = lo[2]; r[3] = lo[3]; r[4] = hi[0]; r[5] = hi[1]; r[6] = hi[2]; r[7] = hi[3]; return r; }
__device__ __forceinline__ bf16x8 pack8(f32x4 a, f32x4 b) { u32x4 w; w.x = cvt_pk_bf16(a[0], a[1]); w.y = cvt_pk_bf16(a[2], a[3]); w.z = cvt_pk_bf16(b[0], b[1]); w.w = cvt_pk_bf16(b[2], b[3]); return __builtin_bit_cast(bf16x8, w); }
__device__ __forceinline__ int lane_id() { int l; asm volatile("v_mbcnt_lo_u32_b32 %0, -1, 0\n\tv_mbcnt_hi_u32_b32 %0, -1, %0" : "=v"(l)); return l; }
#define TIDX (wb + lane_id())
__device__ __forceinline__ f32x4 mfma16(bf16x8 a, bf16x8 b, f32x4 c) { return __builtin_amdgcn_mfma_f32_16x16x32_bf16(a, b, c, 0, 0, 0); }

namespace pg8 {
constexpr int BM = 256, BK = 64, HALF = 128, HTB = HALF * BK * 2, STAGE_BYTES = 8 * HTB, NXCD = 8, WGM = 8;
__host__ __device__ __forceinline__ int lds_byte(int r, int c) { const int st = (r >> 4) * 2 + (c >> 5), rr = r & 15, cc = c & 31, ob = rr * 64 + cc * 2; return st * 1024 + (ob ^ (((ob >> 9) & 1) << 5)); }
__host__ __device__ __forceinline__ void stage_rc(int b, int& R, int& C) { const int st = b / 1024, sb = b % 1024, swz = sb ^ (((sb >> 9) & 1) << 5); R = (st >> 1) * 16 + swz / 64; C = (st & 1) * 32 + (swz % 64) / 2; }
__host__ __device__ __forceinline__ int perm32(int rho) { const int n = rho >> 4, i = rho & 15; return 8 * (i >> 2) + 4 * n + (i & 3); }
struct Unit { int pm, pn; };
struct Gemm { const bf16_t* A; const bf16_t* Bt; int M, N, K; };
struct StaticOrder {
    int nM, nN, nwg, G, c;
    __device__ void init(int M, int N, int G_, int c_) { nM = M / BM; nN = N / BM; nwg = nM * nN; G = G_; c = c_; asm volatile("" : "+s"(c), "+s"(nwg)); }
    __device__ bool next(int i, Unit& u) const {
        const long L = (long)i * G + c; if (L >= nwg) return false;
        int wgid = (int)L; { const int q = nwg / NXCD, r = nwg % NXCD, xcd = wgid % NXCD, off = wgid / NXCD; wgid = (xcd < r ? xcd * (q + 1) : r * (q + 1) + (xcd - r) * q) + off; }
        const int nig = WGM * nN, gid = wgid / nig, fm = gid * WGM, gsz = (nM - fm) < WGM ? (nM - fm) : WGM;
        u.pm = fm + ((wgid % nig) % gsz); u.pn = (wgid % nig) / gsz; return true;
    }
};

struct XqOrder { int pm0, pn; __device__ bool next(int i, Unit& u) const { if (i >= 4) return false; u.pm = pm0 + i; u.pn = pn; return true; } };

template <class Epi, class Sched>
__device__ __forceinline__ void gemm_phase(LAS uchar* lds, const Gemm g, const Sched& S, const Epi& E, int wb) {
    int tid = TIDX; asm volatile("" : "+v"(tid));
    const int wid = __builtin_amdgcn_readfirstlane(tid >> 6), lane = tid & 63, wr = wid >> 2, wc = wid & 3, fr = lane & 15, fq = lane >> 4;
    int K = g.K; const bf16_t* gA = g.A; const bf16_t* gBt = g.Bt;
    asm volatile("" : "+s"(K), "+s"(gA), "+s"(gBt));
    const int nt = K / BK;
    unsigned voffA[2], voffB[2];
#pragma unroll
    for (int i = 0; i < 2; ++i) { int R, C; stage_rc(tid * 16 + i * 8192, R, C); const int Rb = Epi::PERM ? ((R & ~31) + perm32(R & 31)) : R;
        voffA[i] = (unsigned)(R * K + C) * 2u; voffB[i] = (unsigned)(Rb * K + C) * 2u; }
    const size_t kstep = (size_t)(BK * 2);
    const size_t hstep = (size_t)HALF * K * 2;
    const size_t tstep = 2 * hstep;
    const unsigned ldsw = (unsigned)wid * 1024u;
    const int aoff = lds_byte(wr * 64 + fr, fq * 8), boff = lds_byte(wc * 32 + fr, fq * 8);
#define PG8_SA(b, h) (((b) * 2 + (h)) * HTB)
#define PG8_SB(b, h) ((4 + (b) * 2 + (h)) * HTB)
#define PG8_STAGE(bufoff, gbase, voff) do { _Pragma("unroll") for (int _i = 0; _i < 2; ++_i) \
        __builtin_amdgcn_global_load_lds((const unsigned*)((const char*)(gbase) + (voff)[_i]), (LAS unsigned*)(lds + (bufoff) + ldsw + _i * 8192), 16, 0, 0); } while (0)
#define PG8_LDA(dst, b, h) do { _Pragma("unroll") for (int m = 0; m < 4; ++m) _Pragma("unroll") for (int k = 0; k < 2; ++k) dst[m][k] = *(const LAS bf16x8*)(lds + PG8_SA(b, h) + aoff + m * 2048 + k * 1024); } while (0)
#define PG8_LDB(dst, b, h) do { _Pragma("unroll") for (int n = 0; n < 2; ++n) _Pragma("unroll") for (int k = 0; k < 2; ++k) dst[n][k] = *(const LAS bf16x8*)(lds + PG8_SB(b, h) + boff + n * 2048 + k * 1024); } while (0)
#define PG8_MMA(ai, bj, At, Bt) do { __builtin_amdgcn_s_setprio(1); _Pragma("unroll") for (int m = 0; m < 4; ++m) _Pragma("unroll") for (int n = 0; n < 2; ++n) _Pragma("unroll") for (int k = 0; k < 2; ++k) \
        acc[ai][bj][m][n] = __builtin_amdgcn_mfma_f32_16x16x32_bf16(Bt[n][k], At[m][k], acc[ai][bj][m][n], 0, 0, 0); __builtin_amdgcn_s_setprio(0); } while (0)
#define PG8_WAIT_V(n) asm volatile("s_waitcnt vmcnt(" #n ")" ::: "memory")
#define PG8_WAIT_L(n) asm volatile("s_waitcnt lgkmcnt(" #n ")" ::: "memory")
#define PG8_BAR __builtin_amdgcn_s_barrier()
#define PG8_SCHED __builtin_amdgcn_sched_barrier(0)
    Unit cur, nxt; int ui = 0;
    if (!S.next(0, cur)) return;
    f32x4 acc[2][2][4][2];
#pragma unroll
    for (int a = 0; a < 2; ++a)
#pragma unroll
        for (int b = 0; b < 2; ++b)
#pragma unroll
            for (int m = 0; m < 4; ++m)
#pragma unroll
                for (int n = 0; n < 2; ++n) acc[a][b][m][n] = (f32x4){0.f, 0.f, 0.f, 0.f};
    bf16x8 At[4][2], B0[2][2], B1[2][2];
    const char* cA = (const char*)gA + (size_t)cur.pm * tstep; const char* cB = (const char*)gBt + (size_t)cur.pn * tstep;
    PG8_STAGE(PG8_SB(0, 0), cB, voffB); PG8_STAGE(PG8_SA(0, 0), cA, voffA); PG8_STAGE(PG8_SB(0, 1), cB + hstep, voffB); PG8_STAGE(PG8_SA(0, 1), cA + hstep, voffA);
    if (wr == 1) PG8_BAR;
    PG8_WAIT_V(4); PG8_BAR;
    PG8_STAGE(PG8_SB(1, 0), cB + kstep, voffB); PG8_STAGE(PG8_SA(1, 0), cA + kstep, voffA); PG8_STAGE(PG8_SB(1, 1), cB + hstep + kstep, voffB);
    PG8_WAIT_V(6); PG8_BAR;
    for (;;) {
        const bool has_next = S.next(ui + 1, nxt);
        const char* nA = has_next ? (const char*)gA + (size_t)nxt.pm * tstep : cA; const char* nB = has_next ? (const char*)gBt + (size_t)nxt.pn * tstep : cB;
        for (int t = 0; t < nt; t += 2) {
            const bool last = (t == nt - 2);
            const char* a1 = cA + (size_t)(t + 1) * kstep;
            const char* a2 = last ? nA : cA + (size_t)(t + 2) * kstep; const char* b2 = last ? nB : cB + (size_t)(t + 2) * kstep;
            const char* a3 = a2 + kstep; const char* b3 = b2 + kstep;
            PG8_LDB(B0, 0, 0); PG8_SCHED; PG8_LDA(At, 0, 0); PG8_STAGE(PG8_SA(1, 1), a1 + hstep, voffA);
            PG8_WAIT_L(8); PG8_BAR; PG8_WAIT_L(0); PG8_MMA(0, 0, At, B0); PG8_BAR; PG8_SCHED;
            PG8_LDB(B1, 0, 1); PG8_STAGE(PG8_SB(0, 0), b2, voffB);
            PG8_BAR; PG8_WAIT_L(0); PG8_MMA(0, 1, At, B1); PG8_BAR;
            PG8_LDA(At, 0, 1); PG8_STAGE(PG8_SA(0, 0), a2, voffA);
            PG8_BAR; PG8_WAIT_L(0); PG8_MMA(1, 0, At, B0); PG8_BAR; PG8_SCHED;
            PG8_STAGE(PG8_SB(0, 1), b2 + hstep, voffB);
            PG8_WAIT_V(6); PG8_BAR; PG8_MMA(1, 1, At, B1); PG8_BAR;
            PG8_LDB(B0, 1, 0); PG8_SCHED; PG8_LDA(At, 1, 0); PG8_STAGE(PG8_SA(0, 1), a2 + hstep, voffA);
            PG8_WAIT_L(8); PG8_BAR; PG8_WAIT_L(0); PG8_MMA(0, 0, At, B0); PG8_BAR; PG8_SCHED;
            PG8_LDB(B1, 1, 1); PG8_STAGE(PG8_SB(1, 0), b3, voffB);
            PG8_BAR; PG8_WAIT_L(0); PG8_MMA(0, 1, At, B1); PG8_BAR;
            PG8_LDA(At, 1, 1); PG8_STAGE(PG8_SA(1, 0), a3, voffA);
            PG8_BAR; PG8_WAIT_L(0); PG8_MMA(1, 0, At, B0); PG8_BAR; PG8_SCHED;
            PG8_STAGE(PG8_SB(1, 1), b3 + hstep, voffB);
            PG8_WAIT_V(6); PG8_BAR; PG8_MMA(1, 1, At, B1); PG8_BAR;
        }
        { int te = TIDX; asm volatile("" : "+v"(te));
          const int we = __builtin_amdgcn_readfirstlane(te >> 6), le = te & 63; E(acc, cur, we >> 2, we & 3, le & 15, le >> 4); }
        if (!has_next) break;
#pragma unroll
        for (int a = 0; a < 2; ++a)
#pragma unroll
            for (int b = 0; b < 2; ++b)
#pragma unroll
                for (int m = 0; m < 4; ++m)
#pragma unroll
                    for (int n = 0; n < 2; ++n) acc[a][b][m][n] = (f32x4){0.f, 0.f, 0.f, 0.f};
        cur = nxt; cA = nA; cB = nB; ++ui;
    }
    PG8_WAIT_V(0);
    if (wr == 0) PG8_BAR;
    PG8_BAR;
#undef PG8_SA
#undef PG8_SB
#undef PG8_STAGE
#undef PG8_LDA
#undef PG8_LDB
#undef PG8_MMA
#undef PG8_WAIT_V
#undef PG8_WAIT_L
#undef PG8_BAR
#undef PG8_SCHED
}

__device__ __forceinline__ float row_rstd(const float* ss, int row) { const f32x4* q = (const f32x4*)(ss + (size_t)row * 16); const f32x4 a = q[0], b = q[1], c = q[2], d = q[3];
    const float t = (((a[0] + a[1]) + (a[2] + a[3])) + ((b[0] + b[1]) + (b[2] + b[3]))) + (((c[0] + c[1]) + (c[2] + c[3])) + ((d[0] + d[1]) + (d[2] + d[3])));
    return __builtin_amdgcn_rsqf(t * (1.0f / 1024.0f) + EPS); }

__device__ __forceinline__ float row_rstd4(const float* ss, int row, int fq) { const f32x4 a = *(const f32x4*)(ss + (size_t)row * 16 + 4 * fq);
    float t = (a[0] + a[1]) + (a[2] + a[3]); t += __shfl_xor(t, 16); t += __shfl_xor(t, 32);
    return __builtin_amdgcn_rsqf(t * (1.0f / 1024.0f) + EPS); }
struct EpiSwiglu {
    static constexpr bool PERM = true;
    bf16_t* O; const float* rowss;
    __device__ __forceinline__ void operator()(const f32x4 (&acc)[2][2][4][2], const Unit& u, int wr, int wc, int fr, int fq) const {
        const int row0 = u.pm * BM + wr * 64 + fr, col0 = u.pn * 128 + wc * 32 + 8 * fq;
        float rsv[2][4];
#pragma unroll
        for (int ai = 0; ai < 2; ++ai)
#pragma unroll
            for (int m = 0; m < 4; ++m) rsv[ai][m] = row_rstd4(rowss, row0 + ai * HALF + m * 16, fq);
#pragma unroll
        for (int ai = 0; ai < 2; ++ai)
#pragma unroll
            for (int m = 0; m < 4; ++m) { const int row = row0 + ai * HALF + m * 16; const float rs = rsv[ai][m];
                f32x4 o0, o1;
#pragma unroll
                for (int j = 0; j < 4; ++j) { o0[j] = siluf_(acc[ai][0][m][0][j] * rs) * (acc[ai][1][m][0][j] * rs); o1[j] = siluf_(acc[ai][0][m][1][j] * rs) * (acc[ai][1][m][1][j] * rs); }
                *(bf16x8*)(O + (size_t)row * D_FF + col0) = pack8(o0, o1); }
    }
};
struct EpiRes {
    static constexpr bool PERM = true;
    bf16_t* hb; float* rowss_next; float scale;
    __device__ __forceinline__ void operator()(const f32x4 (&acc)[2][2][4][2], const Unit& u, int wr, int wc, int fr, int fq) const {
        const int row0 = u.pm * BM + wr * 64 + fr, col0 = u.pn * BM + wc * 32 + 8 * fq;
        u32x4 rv[2][4][2];
#pragma unroll
        for (int ai = 0; ai < 2; ++ai)
#pragma unroll
            for (int m = 0; m < 4; ++m)
#pragma unroll
                for (int bj = 0; bj < 2; ++bj) rv[ai][m][bj] = *(const u32x4*)(hb + (size_t)(row0 + ai * HALF + m * 16) * D_MODEL + col0 + bj * HALF);
#pragma unroll
        for (int ai = 0; ai < 2; ++ai)
#pragma unroll
            for (int m = 0; m < 4; ++m) { const int row = row0 + ai * HALF + m * 16; float ss = 0.f;
#pragma unroll
                for (int bj = 0; bj < 2; ++bj) { const size_t idx = (size_t)row * D_MODEL + col0 + bj * HALF;
                    const u32x4 r = rv[ai][m][bj];
                    f32x4 h0, h1;
                    h0[0] = bflo(r.x) + acc[ai][bj][m][0][0] * scale; h0[1] = bfhi(r.x) + acc[ai][bj][m][0][1] * scale; h0[2] = bflo(r.y) + acc[ai][bj][m][0][2] * scale; h0[3] = bfhi(r.y) + acc[ai][bj][m][0][3] * scale;
                    h1[0] = bflo(r.z) + acc[ai][bj][m][1][0] * scale; h1[1] = bfhi(r.z) + acc[ai][bj][m][1][1] * scale; h1[2] = bflo(r.w) + acc[ai][bj][m][1][2] * scale; h1[3] = bfhi(r.w) + acc[ai][bj][m][1][3] * scale;
                    *(bf16x8*)(hb + idx) = pack8(h0, h1);
#pragma unroll
                    for (int j = 0; j < 4; ++j) ss += h0[j] * h0[j] + h1[j] * h1[j]; }
                ss += __shfl_xor(ss, 16); ss += __shfl_xor(ss, 32);
                if (fq == 0) rowss_next[(size_t)row * 16 + u.pn * 4 + wc] = ss; }
    }
};
struct EpiScale {
    static constexpr bool PERM = true;
    bf16_t* O; int ldo; const float* rowss; float cs;
    __device__ __forceinline__ void operator()(const f32x4 (&acc)[2][2][4][2], const Unit& u, int wr, int wc, int fr, int fq) const {
        const int row0 = u.pm * BM + wr * 64 + fr, col0 = u.pn * BM + wc * 32 + 8 * fq;
        float rsv[2][4];
#pragma unroll
        for (int ai = 0; ai < 2; ++ai)
#pragma unroll
            for (int m = 0; m < 4; ++m) rsv[ai][m] = row_rstd4(rowss, row0 + ai * HALF + m * 16, fq);
#pragma unroll
        for (int ai = 0; ai < 2; ++ai)
#pragma unroll
            for (int m = 0; m < 4; ++m) { const int row = row0 + ai * HALF + m * 16; const float rs = rsv[ai][m] * cs;
#pragma unroll
                for (int bj = 0; bj < 2; ++bj) *(bf16x8*)(O + (size_t)row * ldo + col0 + bj * HALF) = pack8(acc[ai][bj][m][0] * rs, acc[ai][bj][m][1] * rs); }
    }
};
struct EpiMemKV {
    static constexpr bool PERM = true;
    bf16_t* KX; bf16_t* VXT; const float* rowss;
    __device__ __forceinline__ void operator()(const f32x4 (&acc)[2][2][4][2], const Unit& u, int wr, int wc, int fr, int fq) const {
        const int row0 = u.pm * BM + wr * 64 + fr, col0 = u.pn * BM + wc * 32 + 8 * fq;
#pragma unroll
        for (int ai = 0; ai < 2; ++ai)
#pragma unroll
            for (int m = 0; m < 4; ++m) { const int row = row0 + ai * HALF + m * 16; const float rs = row_rstd(rowss, row);
#pragma unroll
                for (int bj = 0; bj < 2; ++bj) { const int col = col0 + bj * HALF;
                    if (u.pn < 4) { *(bf16x8*)(KX + (size_t)row * 1024 + col) = pack8(acc[ai][bj][m][0] * rs, acc[ai][bj][m][1] * rs); }
                    else { const int j0 = row & 255, jrow = (j0 & ~31) | (8 * ((j0 >> 2) & 3) + 4 * ((j0 >> 4) & 1) + (j0 & 3));
                        bf16_t* vp = VXT + ((size_t)u.pm * 1024 + (col - 1024)) * 256 + jrow;
#pragma unroll
                        for (int n = 0; n < 2; ++n)
#pragma unroll
                            for (int j = 0; j < 4; ++j) vp[(size_t)(4 * n + j) * 256] = (bf16_t)(cvt_pk_bf16(acc[ai][bj][m][n][j] * rs, 0.f) & 0xffffu); } } }
    }
};
}

__device__ __forceinline__ void convert_tile(LAS uchar* lds, const float* W, int K, int N, bf16_t* dst, int rs, int off, const float* gain, int tile, int wb) {
    int tid = TIDX; asm volatile("" : "+v"(tid)); LAS float* T = (LAS float*)lds;
    const int ntn = N >> 8, tk = tile / ntn, tn = tile - tk * ntn, k0 = tk * 64, n0 = tn * 256;
    { const int kk = tid >> 3, c8 = (tid & 7) * 8; const float* src = W + (size_t)(k0 + kk) * N + n0 + c8; const float gk = gain ? gain[k0 + kk] : 1.0f;
      f32x4 a[4], b[4];
#pragma unroll
      for (int q = 0; q < 4; ++q) { a[q] = *(const f32x4*)(src + 64 * q); b[q] = *(const f32x4*)(src + 64 * q + 4); }
#pragma unroll
      for (int q = 0; q < 4; ++q)
#pragma unroll
          for (int j = 0; j < 4; ++j) { T[q * 4160 + kk * 65 + c8 + j] = a[q][j] * gk; T[q * 4160 + kk * 65 + c8 + 4 + j] = b[q][j] * gk; } }
    __syncthreads();
    { const int n = tid >> 3, k8 = (tid & 7) * 8;
#pragma unroll
      for (int q = 0; q < 4; ++q) { f32x4 a, b;
#pragma unroll
          for (int j = 0; j < 4; ++j) { a[j] = T[q * 4160 + (k8 + j) * 65 + n]; b[j] = T[q * 4160 + (k8 + 4 + j) * 65 + n]; }
          const int nn = n0 + 64 * q + n, drow = (nn >> 7) * rs + (nn & 127) + off;
          *(bf16x8*)(dst + (size_t)drow * K + k0 + k8) = pack8(a, b); } }
    __syncthreads();
}
__device__ __forceinline__ void convert_weight(LAS uchar* lds, const float* W, int K, int N, bf16_t* dst, int rs, int off, const float* gain, int& base, int wb) {
    const int G = gridDim.x, nt = (K >> 6) * (N >> 8);
    for (int t = (int)((blockIdx.x + G - (base % G)) % G); t < nt; t += G) convert_tile(lds, W, K, N, dst, rs, off, gain, t, wb);
    base += nt;
}
__device__ __forceinline__ void convert_rows(const float* __restrict__ X, bf16_t* __restrict__ Xb, float* __restrict__ ss, int nrows, int wb) {
    int tid_ = TIDX; asm volatile("" : "+v"(tid_));
    const int lane = tid_ & 63, gw = blockIdx.x * 8 + (tid_ >> 6), nw = gridDim.x * 8;
    for (int r0 = gw * 4; r0 < nrows; r0 += nw * 4) {
        f32x4 v[4][4];
#pragma unroll
        for (int q = 0; q < 4; ++q)
#pragma unroll
            for (int i = 0; i < 4; ++i) v[q][i] = *(const f32x4*)(X + (size_t)(r0 + q) * 1024 + i * 256 + lane * 4);
#pragma unroll
        for (int q = 0; q < 4; ++q) { bf16_t* dp = Xb + (size_t)(r0 + q) * 1024; float s = 0.f;
#pragma unroll
            for (int i = 0; i < 4; ++i) { const f32x4 x = v[q][i]; s += x[0] * x[0] + x[1] * x[1] + x[2] * x[2] + x[3] * x[3];
                u32x2 w; w.x = cvt_pk_bf16(x[0], x[1]); w.y = cvt_pk_bf16(x[2], x[3]); *(u32x2*)(dp + i * 256 + lane * 4) = w; }
#pragma unroll
            for (int o = 32; o >= 1; o >>= 1) s += __shfl_xor(s, o);
            if (lane < 16) ss[(size_t)(r0 + q) * 16 + lane] = lane == 0 ? s : 0.f; } }
}
__device__ __forceinline__ void final_norm(float* __restrict__ out, const bf16_t* __restrict__ hb, const float* __restrict__ ss, const float* __restrict__ gain, size_t nprobe, int wb) {
    int tid_ = TIDX; asm volatile("" : "+v"(tid_));
    const int lane = tid_ & 63, gw = blockIdx.x * 8 + (tid_ >> 6), nw = gridDim.x * 8;
    f32x4 gv[4];
#pragma unroll
    for (int i = 0; i < 4; ++i) gv[i] = *(const f32x4*)(gain + i * 256 + lane * 4);
    for (int r0 = gw * 4; r0 < NTOK; r0 += nw * 4) {
        u32x2 hv[4][4]; float rs[4];
#pragma unroll
        for (int q = 0; q < 4; ++q) { rs[q] = pg8::row_rstd(ss, r0 + q);
#pragma unroll
            for (int i = 0; i < 4; ++i) hv[q][i] = *(const u32x2*)(hb + (size_t)(r0 + q) * 1024 + i * 256 + lane * 4); }
#pragma unroll
        for (int q = 0; q < 4; ++q) { float* p = out + (size_t)(r0 + q) * 1024;
#pragma unroll
            for (int i = 0; i < 4; ++i) { f32x4 v; v[0] = bflo(hv[q][i].x); v[1] = bfhi(hv[q][i].x); v[2] = bflo(hv[q][i].y); v[3] = bfhi(hv[q][i].y); v = v * rs[q] * gv[i];
#if PROBE_WHICH
                { const size_t li = (size_t)(r0 + q) * 1024 + i * 256 + lane * 4;
#pragma unroll
                  for (int j = 0; j < 4; ++j) if (li + j < nprobe) v[j] += 0.0625f; }
#endif
                *(f32x4*)(p + i * 256 + lane * 4) = v; } } }
}

constexpr int HG_ROW = 272, HG_PROW = 144;
constexpr int HG_QD = 0, HG_KD = 64 * HG_ROW, HG_VV = 2 * 64 * HG_ROW, HG_PP = 3 * 64 * HG_ROW, HG_SREF = HG_PP + 64 * HG_PROW, HG_SE2 = HG_SREF + 512, HG_RED = HG_SE2 + 512, HG_DIR_BYTES = HG_RED + 1024;
static_assert(2 * HG_DIR_BYTES <= LDS_BYTES - 64, "hgrn lds");

__device__ void hgrn_unit(LAS uchar* lds_all, const Params& p, int layer, int unit, int wb) {
    int tid = TIDX; asm volatile("" : "+v"(tid));
    const int lane = tid & 63, wid = __builtin_amdgcn_readfirstlane(tid >> 6), dir = wid >> 2, w = wid & 3, dtid = tid & 255;
    const int fr = lane & 15, g = lane >> 4, q_ = fr >> 2, p_ = fr & 3;
    const int b = unit >> 2, hd = unit & 3;
    LAS uchar* L = lds_all + dir * HG_DIR_BYTES;
    const bf16_t* proj = (const bf16_t*)(p.ws + WS_BIG) + (size_t)b * SEQ * IN_COLS;
    float* tmp = p.out + (size_t)b * SEQ * 512;
    bf16_t* Y = (bf16_t*)(p.ws + WS_Y) + (size_t)b * SEQ * 1024;
    const int pk = dtid & 127, half = __builtin_amdgcn_readfirstlane(dtid >> 7);
    float lb = 0.f;
    if (layer == 1) { const float l0 = p.lb_logits[(0 * 2 + dir) * 512 + hd * 128 + pk], l1 = p.lb_logits[(1 * 2 + dir) * 512 + hd * 128 + pk]; lb = sigmoidf_(l1 - l0); }
    const float omlb = 1.0f - lb;
    const int zcol = 1024 + dir * 512 + hd * 128 + pk, qcol = hd * 128 + pk;

    f32x4 sacc[8][2];
#pragma unroll
    for (int kt = 0; kt < 8; ++kt) { sacc[kt][0] = (f32x4){0.f, 0.f, 0.f, 0.f}; sacc[kt][1] = (f32x4){0.f, 0.f, 0.f, 0.f}; }

    unsigned short zr[32], qr[32];
#define HG_PREFETCH(stp, i0, i1) do { const int _t0 = (dir == 0 ? (stp) : 31 - (stp)) * 64; \
        _Pragma("unroll") for (int i = (i0); i < (i1); ++i) { const int tau = half ? 32 + i : 31 - i; const int tl = dir == 0 ? tau : 63 - tau; const unsigned ro = (unsigned)((_t0 + tl) * IN_COLS) * 2u; \
            zr[i] = *(const bf16_t*)((const char*)proj + ro + zcol * 2); qr[i] = *(const bf16_t*)((const char*)proj + ro + qcol * 2); } } while (0)
    constexpr int HG_PF = 24;
    HG_PREFETCH(0, 0, HG_PF);
    for (int step = 0; step < 32; ++step) {
        const int tok0 = (dir == 0 ? step : 31 - step) * 64;
        {
            u32x4 vrow[4];
            { const int rowi = dtid >> 2, seg = dtid & 3; const unsigned so = (unsigned)((tok0 + rowi) * IN_COLS + 512 + hd * 128 + seg * 32) * 2u;
#pragma unroll
              for (int i = 0; i < 4; ++i) vrow[i] = *(const u32x4*)((const char*)proj + so + i * 16); }
            HG_PREFETCH(step, HG_PF, 32);
            float E = 1.0f;
#pragma unroll
            for (int i = 0; i < 32; ++i) { const int tau = half ? 32 + i : 31 - i;
                const float z = bf2f(zr[i]), q = bf2f(qr[i]); const float s = sigmoidf_(z), f = lb + omlb * s, kk = omlb * (1.0f - s);
                float qd, kd;
                if (half) { E = fmaxf(E * f, 1e-30f); qd = q * E; kd = kk * fast_rcp(E); }
                else { qd = q * fast_rcp(E); kd = kk * E; E = fmaxf(E * f, 1e-30f); }
                *(LAS bf16_t*)(L + HG_QD + tau * HG_ROW + pk * 2) = (bf16_t)(cvt_pk_bf16(qd, 0.f) & 0xffffu);
                *(LAS bf16_t*)(L + HG_KD + tau * HG_ROW + pk * 2) = (bf16_t)(cvt_pk_bf16(kd, 0.f) & 0xffffu); }
            *(LAS float*)(L + (half ? HG_SE2 : HG_SREF) + pk * 4) = E;
            { const int rowi = dtid >> 2, seg = dtid & 3, tau = dir == 0 ? rowi : 63 - rowi;
#pragma unroll
              for (int i = 0; i < 4; ++i) *(LAS u32x4*)(L + HG_VV + tau * HG_ROW + seg * 64 + i * 16) = vrow[i]; }
        }
        __syncthreads();
        bf16x8 qbs[4];
#pragma unroll
        for (int ks = 0; ks < 4; ++ks) qbs[ks] = *(const LAS bf16x8*)(L + HG_QD + (16 * w + fr) * HG_ROW + (32 * ks + 8 * g) * 2);
#pragma unroll
        for (int st = 0; st < 4; ++st) { f32x4 a = (f32x4){0.f, 0.f, 0.f, 0.f};
            if (st <= w) { bf16x8 kas[4];
#pragma unroll
                for (int ks = 0; ks < 4; ++ks) kas[ks] = *(const LAS bf16x8*)(L + HG_KD + (16 * st + fr) * HG_ROW + (32 * ks + 8 * g) * 2);
#pragma unroll
                for (int ks = 0; ks < 4; ++ks) a = mfma16(kas[ks], qbs[ks], a);
#pragma unroll
                for (int r = 0; r < 4; ++r) if (16 * st + 4 * g + r > 16 * w + fr) a[r] = 0.f; }
            u32x2 pw; pw.x = cvt_pk_bf16(a[0], a[1]); pw.y = cvt_pk_bf16(a[2], a[3]);
            *(LAS u32x2*)(L + HG_PP + (16 * w + fr) * HG_PROW + (16 * st + 4 * g) * 2) = pw; }
#pragma unroll
        for (int kt = 0; kt < 8; ++kt) { const f32x4 sr = *(const LAS f32x4*)(L + HG_SREF + (16 * kt + 4 * g) * 4); sacc[kt][0] *= sr; sacc[kt][1] *= sr; }
        bf16x8 vf[2][2];
#pragma unroll
        for (int vt = 0; vt < 2; ++vt)
#pragma unroll
            for (int ks = 0; ks < 2; ++ks) { const LAS uchar* a = L + HG_VV + (32 * ks + 8 * g + q_) * HG_ROW + (32 * w + 16 * vt + 4 * p_) * 2; vf[vt][ks] = cat8(tr_read(a), tr_read(a + 4 * HG_ROW)); }
        __syncthreads();
        if (step + 1 < 32) { HG_PREFETCH(step + 1, 0, HG_PF); }
        f32x4 oacc[2][4];
#pragma unroll
        for (int vt = 0; vt < 2; ++vt)
#pragma unroll
            for (int tt = 0; tt < 4; ++tt) oacc[vt][tt] = (f32x4){0.f, 0.f, 0.f, 0.f};
        { bf16x8 pbs[4][2];
#pragma unroll
          for (int tt = 0; tt < 4; ++tt)
#pragma unroll
              for (int ks = 0; ks < 2; ++ks) pbs[tt][ks] = *(const LAS bf16x8*)(L + HG_PP + (16 * tt + fr) * HG_PROW + (32 * ks + 8 * g) * 2);
          __builtin_amdgcn_sched_barrier(0);
#pragma unroll
          for (int tt = 0; tt < 4; ++tt)
#pragma unroll
              for (int ks = 0; ks < 2; ++ks) { oacc[0][tt] = mfma16(vf[0][ks], pbs[tt][ks], oacc[0][tt]); oacc[1][tt] = mfma16(vf[1][ks], pbs[tt][ks], oacc[1][tt]); } }
#pragma unroll
        for (int ks = 0; ks < 4; ++ks) { const bf16x8 sa0 = pack8(sacc[2 * ks][0], sacc[2 * ks + 1][0]), sa1 = pack8(sacc[2 * ks][1], sacc[2 * ks + 1][1]);
            u32x2 qlo[4], qhi[4];
#pragma unroll
            for (int tt = 0; tt < 4; ++tt) { const LAS uchar* qa = L + HG_QD + (16 * tt + fr) * HG_ROW + (32 * ks + 4 * g) * 2; qlo[tt] = *(const LAS u32x2*)qa; qhi[tt] = *(const LAS u32x2*)(qa + 32); }
#pragma unroll
            for (int tt = 0; tt < 4; ++tt) { u32x4 qq; qq.x = qlo[tt].x; qq.y = qlo[tt].y; qq.z = qhi[tt].x; qq.w = qhi[tt].y;
                const bf16x8 qb = __builtin_bit_cast(bf16x8, qq);
                oacc[0][tt] = mfma16(sa0, qb, oacc[0][tt]); oacc[1][tt] = mfma16(sa1, qb, oacc[1][tt]); } }
#pragma unroll
        for (int kt = 0; kt < 8; ++kt) {
            s16x4 t0[2], t1[2];
#pragma unroll
            for (int ks = 0; ks < 2; ++ks) { const LAS uchar* a = L + HG_KD + (32 * ks + 8 * g + q_) * HG_ROW + (16 * kt + 4 * p_) * 2; t0[ks] = tr_read(a); t1[ks] = tr_read(a + 4 * HG_ROW); }
            const f32x4 e2 = *(const LAS f32x4*)(L + HG_SE2 + (16 * kt + 4 * g) * 4);
#pragma unroll
            for (int ks = 0; ks < 2; ++ks) { const bf16x8 ka = cat8(t0[ks], t1[ks]);
                sacc[kt][0] = mfma16(ka, vf[0][ks], sacc[kt][0]); sacc[kt][1] = mfma16(ka, vf[1][ks], sacc[kt][1]); }
            sacc[kt][0] *= e2; sacc[kt][1] *= e2; }
        const bool second = step >= 16;
        float ssq[4];
#pragma unroll
        for (int tt = 0; tt < 4; ++tt) { const int tau = 16 * tt + fr, tl = dir == 0 ? tau : 63 - tau; float s = 0.f;
#pragma unroll
            for (int vt = 0; vt < 2; ++vt) { float* tp = tmp + (size_t)(tok0 + tl) * 512 + hd * 128 + 32 * w + 16 * vt + 4 * g;
                if (!second) *(f32x4*)tp = oacc[vt][tt];
                else { oacc[vt][tt] += *(const f32x4*)tp; const f32x4 o = oacc[vt][tt]; s += o[0] * o[0] + o[1] * o[1] + o[2] * o[2] + o[3] * o[3]; } }
            ssq[tt] = s; }
        if (second) {
#pragma unroll
            for (int tt = 0; tt < 4; ++tt) { float s = ssq[tt]; s += __shfl_xor(s, 16); s += __shfl_xor(s, 32); if (g == 0) *(LAS float*)(L + HG_RED + (w * 64 + 16 * tt + fr) * 4) = s; } }
        __syncthreads();
        if (second) {
#pragma unroll
            for (int tt = 0; tt < 4; ++tt) { const int tau = 16 * tt + fr, tl = dir == 0 ? tau : 63 - tau;
                const float tot = *(const LAS float*)(L + HG_RED + tau * 4) + *(const LAS float*)(L + HG_RED + (64 + tau) * 4) + *(const LAS float*)(L + HG_RED + (128 + tau) * 4) + *(const LAS float*)(L + HG_RED + (192 + tau) * 4);
                const float rs = __builtin_amdgcn_rsqf(tot * (1.0f / 128.0f) + EPS);
#pragma unroll
                for (int vt = 0; vt < 2; ++vt) { const int v = hd * 128 + 32 * w + 16 * vt + 4 * g;
                    const f32x4 gn = *(const f32x4*)(p.hgrn_gain + layer * 512 + v);
                    const u32x2 gt = *(const u32x2*)(proj + (size_t)(tok0 + tl) * IN_COLS + 2048 + v);
                    const f32x4 o = oacc[vt][tt] * rs * gn;
                    u32x2 yw; yw.x = cvt_pk_bf16(o[0] * siluf_(bflo(gt.x)), o[1] * siluf_(bfhi(gt.x))); yw.y = cvt_pk_bf16(o[2] * siluf_(bflo(gt.y)), o[3] * siluf_(bfhi(gt.y)));
                    *(u32x2*)(Y + (size_t)(tok0 + tl) * 1024 + v) = yw; } } }
    }
    __syncthreads();
}

constexpr int DK_ROW = 144;
constexpr int DA_OROW = 136, DA_OB = 0, DA_LSE = 256 * DA_OROW, DA_KS = DA_LSE + 1024, DA_NROWS = 384, DA_VS = DA_KS + DA_NROWS * DK_ROW;
static_assert(DA_VS + DA_NROWS * DK_ROW <= LDS_BYTES - 64, "dattn lds");
constexpr size_t OUT_OC = (size_t)NTOK * 512 * 4;
constexpr size_t OUT_LSEC = OUT_OC + (size_t)NTOK * 512 * 2;

__device__ __forceinline__ void da_task(const LAS uchar* ks0, const LAS uchar* vs0, int origin, int cl_lo, int cl_hi, int mq0, int Ls, float sd, const bf16x8 q0, const bf16x8 q1,
                                        int fr, int g, int q_, int p_, f32x4 (&oacc)[4], float& mx_out, float& ls_out) {
    float NEG_INF = -__builtin_inff(); asm volatile("" : "+v"(NEG_INF));
    bf16x8 kf[9][2];
#pragma unroll
    for (int it = 0; it < 9; ++it) { const int mk0 = mq0 - 64 + 16 * it; const int mkc = mk0 < cl_lo ? cl_lo : (mk0 > cl_hi ? cl_hi : mk0);
        const LAS uchar* kp = ks0 + (mkc - origin + fr) * DK_ROW + 16 * g; kf[it][0] = *(const LAS bf16x8*)kp; kf[it][1] = *(const LAS bf16x8*)(kp + 64); }
    f32x4 sc[9];
    float c1 = 0.125f * 1.44269504089f; asm volatile("" : "+v"(c1));
    const float sd2 = sd * 1.44269504089f, basef = (float)(4 * g - fr - 64);
#pragma unroll
    for (int it = 0; it < 9; ++it) { const int mk0 = mq0 - 64 + 16 * it; const bool valid = (mk0 >= 0) && (mk0 < Ls);
        f32x4 a = (f32x4){0.f, 0.f, 0.f, 0.f}; a = mfma16(kf[it][0], q0, a); a = mfma16(kf[it][1], q1, a);
#pragma unroll
        for (int rg = 0; rg < 4; ++rg) { const float relf = basef + (float)(16 * it + rg); float sv = a[rg] * c1 - sd2 * __builtin_fabsf(relf);
            if (it == 0) sv = (4 * g + rg >= fr) ? sv : NEG_INF;
            if (it == 8) sv = (4 * g + rg <= fr) ? sv : NEG_INF;
            a[rg] = valid ? sv : NEG_INF; }
        sc[it] = a; }
    __builtin_amdgcn_sched_barrier(0);
    s16x4 vlo[5][4], vhi[5][4];
#pragma unroll
    for (int pi = 0; pi < 5; ++pi) { const int ta = 2 * pi, tb = pi < 4 ? 2 * pi + 1 : 8;
        const int ma = mq0 - 64 + 16 * ta, mb = mq0 - 64 + 16 * tb;
        const int mca = ma < cl_lo ? cl_lo : (ma > cl_hi ? cl_hi : ma), mcb = mb < cl_lo ? cl_lo : (mb > cl_hi ? cl_hi : mb);
        const LAS uchar* va = vs0 + (mca - origin + 4 * g + q_) * DK_ROW + 8 * p_;
        const LAS uchar* vb = vs0 + (mcb - origin + 4 * g + q_) * DK_ROW + 8 * p_;
#pragma unroll
        for (int dt = 0; dt < 4; ++dt) { vlo[pi][dt] = tr_read(va + 32 * dt); vhi[pi][dt] = tr_read(vb + 32 * dt); } }
    __builtin_amdgcn_sched_barrier(0);
    float mx = NEG_INF;
#pragma unroll
    for (int it = 0; it < 9; ++it) mx = fmaxf(fmaxf(fmaxf(sc[it][0], sc[it][1]), fmaxf(sc[it][2], sc[it][3])), mx);
    mx = fmaxf(mx, __shfl_xor(mx, 16)); mx = fmaxf(mx, __shfl_xor(mx, 32));
    float ls = 0.f;
#pragma unroll
    for (int it = 0; it < 9; ++it)
#pragma unroll
        for (int rg = 0; rg < 4; ++rg) { const float e = __builtin_amdgcn_exp2f(sc[it][rg] - mx); sc[it][rg] = e; ls += e; }
    ls += __shfl_xor(ls, 16); ls += __shfl_xor(ls, 32);
#pragma unroll
    for (int dt = 0; dt < 4; ++dt) oacc[dt] = (f32x4){0.f, 0.f, 0.f, 0.f};
#pragma unroll
    for (int pi = 0; pi < 5; ++pi) {
        const bf16x8 pb = pack8(sc[2 * pi], pi < 4 ? sc[2 * pi + 1] : (f32x4){0.f, 0.f, 0.f, 0.f});
#pragma unroll
        for (int dt = 0; dt < 4; ++dt) oacc[dt] = mfma16(cat8(vlo[pi][dt], vhi[pi][dt]), pb, oacc[dt]);
    }
    mx_out = mx * 0.69314718056f; ls_out = ls;
}

__device__ void dattn16_unit(LAS uchar* lds, const Params& p, int unit, unsigned* done, int wb) {
    int tid = TIDX; asm volatile("" : "+v"(tid));
    const int lane = tid & 63, wid = __builtin_amdgcn_readfirstlane(tid >> 6);
    const int fr = lane & 15, g = lane >> 4, q_ = fr >> 2, p_ = fr & 3;
    const int b = unit >> 6, head = (unit >> 3) & 7, rp = unit & 7;
    const bf16_t* proj = (const bf16_t*)(p.ws + WS_BIG) + (size_t)b * SEQ * IN_COLS;
    bf16_t* OC = (bf16_t*)((uchar*)p.out + OUT_OC) + (size_t)b * SEQ * 512;
    float* LSEC = (float*)((uchar*)p.out + OUT_LSEC) + (size_t)b * SEQ * 8;
    constexpr int KS = 0, VS = 2 * 128 * DK_ROW;
    __syncthreads();
#pragma unroll
    for (int i = 0; i < 8; ++i) { const int c = tid + 512 * i, kv = c >> 11, cc = c & 2047, res = cc >> 10, m = (cc >> 3) & 127, ch = cc & 7;
        const unsigned so = (unsigned)((16 * m + 2 * rp + res) * IN_COLS + (kv ? 3584 : 3072) + head * 64 + ch * 8) * 2u;
        *(LAS u32x4*)(lds + (kv ? VS : KS) + (res * 128 + m) * DK_ROW + ch * 16) = *(const u32x4*)((const char*)proj + so); }
    __syncthreads();
    const float sd = __builtin_amdgcn_exp2f(-(float)(head + 1)) * 16.0f;
#pragma unroll 1
    for (int res = 0; res < 2; ++res) {
        const int r = 2 * rp + res, mq0 = 16 * wid, tok = 16 * (mq0 + fr) + r;
        bf16x8 q0, q1;
        { const unsigned qo = (unsigned)(tok * IN_COLS + 2560 + head * 64 + 8 * g) * 2u; q0 = *(const bf16x8*)((const char*)proj + qo); q1 = *(const bf16x8*)((const char*)proj + qo + 64); }
        f32x4 oacc[4]; float mx, ls;
        da_task(lds + KS + res * 128 * DK_ROW, lds + VS + res * 128 * DK_ROW, 0, 0, 112, mq0, 128, sd, q0, q1, fr, g, q_, p_, oacc, mx, ls);
        const float inv = fast_rcp(ls);
#pragma unroll
        for (int dt = 0; dt < 4; ++dt) { u32x2 w2; w2.x = cvt_pk_bf16(oacc[dt][0] * inv, oacc[dt][1] * inv); w2.y = cvt_pk_bf16(oacc[dt][2] * inv, oacc[dt][3] * inv);
            __hip_atomic_store((unsigned long long*)(OC + (size_t)tok * 512 + head * 64 + 16 * dt + 4 * g), ((unsigned long long)w2.y << 32) | w2.x, __ATOMIC_RELAXED, __HIP_MEMORY_SCOPE_AGENT); }
        if (g == 0) __hip_atomic_store(LSEC + (size_t)tok * 8 + head, mx + __logf(ls), __ATOMIC_RELAXED, __HIP_MEMORY_SCOPE_AGENT);
    }
    __syncthreads();
    if (tid == 0) __hip_atomic_fetch_add(done, 1u, __ATOMIC_RELAXED, __HIP_MEMORY_SCOPE_AGENT);
}

__device__ void dattn_unit(LAS uchar* lds, const Params& p, int unit, const unsigned* done, int& seen_done, int wb) {
    int tid = TIDX; asm volatile("" : "+v"(tid));
    const int lane = tid & 63, wid = __builtin_amdgcn_readfirstlane(tid >> 6);
    const int fr = lane & 15, g = lane >> 4, q_ = fr >> 2, p_ = fr & 3;
    const int b = unit >> 6, head = (unit >> 3) & 7, qb = unit & 7, t0 = qb * 256;
    const bf16_t* proj = (const bf16_t*)(p.ws + WS_BIG) + (size_t)b * SEQ * IN_COLS;
    bf16_t* Y = (bf16_t*)(p.ws + WS_Y) + (size_t)b * SEQ * 1024;
    const float slope = __builtin_amdgcn_exp2f(-(float)(head + 1));
    u32x4 sreg[12];
#define DA_LOAD1(i0, i1) do { _Pragma("unroll") for (int i = (i0); i < (i1); ++i) { const int c = tid + 512 * i, kv = c >= 3072 ? 1 : 0, cc = c - kv * 3072, row = cc >> 3, ch = cc & 7; \
        int tok = t0 - 64 + row; tok = tok < 0 ? 0 : (tok > SEQ - 1 ? SEQ - 1 : tok); \
        sreg[i] = *(const u32x4*)((const char*)proj + (unsigned)(tok * IN_COLS + (kv ? 3584 : 3072) + head * 64 + ch * 8) * 2u); } } while (0)
#define DA_LOAD4(h, i0, i1) do { int tl_ = tid; asm volatile("" : "+v"(tl_)); _Pragma("unroll") for (int i = (i0); i < (i1); ++i) { const int c = tl_ + 512 * i, kv = c >= 3072 ? 1 : 0, cc = c - kv * 3072, rowi = cc >> 3, ch = cc & 7, res = rowi >= 192 ? 1 : 0, mrow = rowi - res * 192; \
        int m = (t0 >> 2) - 64 + mrow; m = m < 0 ? 0 : (m > 511 ? 511 : m); \
        sreg[i] = *(const u32x4*)((const char*)proj + (unsigned)((4 * m + 2 * (h) + res) * IN_COLS + (kv ? 3584 : 3072) + head * 64 + ch * 8) * 2u); } } while (0)
#define DA_WRITE() do { int tw_ = tid; asm volatile("" : "+v"(tw_)); _Pragma("unroll") for (int i = 0; i < 12; ++i) { const int c = tw_ + 512 * i, kv = c >= 3072 ? 1 : 0, cc = c - kv * 3072, rowi = cc >> 3, ch = cc & 7; \
        *(LAS u32x4*)(lds + (kv ? DA_VS : DA_KS) + rowi * DK_ROW + ch * 16) = sreg[i]; } } while (0)
    constexpr int DA_PF = 10;
    DA_LOAD1(0, 12);
    __syncthreads();
    DA_WRITE();
    __syncthreads();
    DA_LOAD4(0, 0, DA_PF);
#pragma unroll 1
    for (int t = 0; t < 2; ++t) { const int j = 2 * wid + t, mq0 = t0 + 16 * j, tok = mq0 + fr;
        bf16x8 q0, q1;
        { const unsigned qo = (unsigned)(tok * IN_COLS + 2560 + head * 64 + 8 * g) * 2u; q0 = *(const bf16x8*)((const char*)proj + qo); q1 = *(const bf16x8*)((const char*)proj + qo + 64); }
        f32x4 oacc[4]; float mx, ls;
        da_task(lds + DA_KS, lds + DA_VS, t0 - 64, t0 - 64, t0 + 304, mq0, SEQ, slope, q0, q1, fr, g, q_, p_, oacc, mx, ls);
        const float inv = fast_rcp(ls); const int tl = 16 * j + fr;
#pragma unroll
        for (int dt = 0; dt < 4; ++dt) { u32x2 w2; w2.x = cvt_pk_bf16(oacc[dt][0] * inv, oacc[dt][1] * inv); w2.y = cvt_pk_bf16(oacc[dt][2] * inv, oacc[dt][3] * inv);
            *(LAS u32x2*)(lds + DA_OB + tl * DA_OROW + (16 * dt + 4 * g) * 2) = w2; }
        if (g == 0) *(LAS float*)(lds + DA_LSE + tl * 4) = mx + __logf(ls);
    }
#pragma unroll
    for (int h = 0; h < 2; ++h) {
        DA_LOAD4(h, DA_PF, 12);
        __syncthreads();
        DA_WRITE();
        __syncthreads();
        if (h == 0) { DA_LOAD4(1, 0, DA_PF); }
        const int mbase = t0 >> 2;
        const int res = wid >> 2, jj = wid & 3, r = 2 * h + res, mq0 = mbase + 16 * jj, tok = 4 * (mq0 + fr) + r;
        bf16x8 q0, q1;
        { const unsigned qo = (unsigned)(tok * IN_COLS + 2560 + head * 64 + 8 * g) * 2u; q0 = *(const bf16x8*)((const char*)proj + qo); q1 = *(const bf16x8*)((const char*)proj + qo + 64); }
        f32x4 oacc[4]; float mx, ls;
        da_task(lds + DA_KS + res * 192 * DK_ROW, lds + DA_VS + res * 192 * DK_ROW, mbase - 64, mbase - 64, mbase + 112, mq0, 512, slope * 4.0f, q0, q1, fr, g, q_, p_, oacc, mx, ls);
        const int tl = tok - t0;
        const float lse_c = mx + __logf(ls), lse_p = *(const LAS float*)(lds + DA_LSE + tl * 4);
        const float Lm = fmaxf(lse_c, lse_p), wc0 = fast_exp(lse_c - Lm), wp0 = fast_exp(lse_p - Lm), winv = fast_rcp(wc0 + wp0), wc = wc0 * winv * fast_rcp(ls), wp = wp0 * winv;
#pragma unroll
        for (int dt = 0; dt < 4; ++dt) { LAS u32x2* op = (LAS u32x2*)(lds + DA_OB + tl * DA_OROW + (16 * dt + 4 * g) * 2); const u32x2 pv = *op;
            u32x2 w2; w2.x = cvt_pk_bf16(wp * bflo(pv.x) + wc * oacc[dt][0], wp * bfhi(pv.x) + wc * oacc[dt][1]); w2.y = cvt_pk_bf16(wp * bflo(pv.y) + wc * oacc[dt][2], wp * bfhi(pv.y) + wc * oacc[dt][3]); *op = w2; }
        if (g == 0) *(LAS float*)(lds + DA_LSE + tl * 4) = Lm + __logf(wc0 + wp0);
    }
#undef DA_LOAD1
#undef DA_LOAD4
#undef DA_WRITE
    if (!seen_done) {
        if (tid == 0) { while (__hip_atomic_load(done, __ATOMIC_RELAXED, __HIP_MEMORY_SCOPE_AGENT) < 256u) __builtin_amdgcn_s_sleep(8); __builtin_amdgcn_fence(__ATOMIC_ACQUIRE, "agent"); }
        seen_done = 1;
    }
    __syncthreads();
    { const int tl = tid >> 1, hf = tid & 1;
      const bf16_t* OC = (const bf16_t*)((const uchar*)p.out + OUT_OC) + ((size_t)b * SEQ + t0 + tl) * 512 + head * 64 + hf * 32;
      const float* LSEC = (const float*)((const uchar*)p.out + OUT_LSEC) + ((size_t)b * SEQ + t0 + tl) * 8 + head;
      const float l0 = *(const LAS float*)(lds + DA_LSE + tl * 4), l2 = __builtin_nontemporal_load(LSEC);
      const float M = fmaxf(l0, l2); float w0 = fast_exp(l0 - M), w2 = fast_exp(l2 - M); const float inv = fast_rcp(w0 + w2); w0 *= inv; w2 *= inv;
      bf16_t* yp = Y + (size_t)(t0 + tl) * 1024 + 512 + head * 64 + hf * 32;
#pragma unroll
      for (int c = 0; c < 4; ++c) { const u32x4 cv = __builtin_nontemporal_load((const u32x4*)(OC + 8 * c)); f32x4 o[2];
          const u32x2 a0 = *(const LAS u32x2*)(lds + DA_OB + tl * DA_OROW + (hf * 32 + 8 * c) * 2), a1 = *(const LAS u32x2*)(lds + DA_OB + tl * DA_OROW + (hf * 32 + 8 * c + 4) * 2);
          o[0][0] = w0 * bflo(a0.x) + w2 * bflo(cv.x); o[0][1] = w0 * bfhi(a0.x) + w2 * bfhi(cv.x); o[0][2] = w0 * bflo(a0.y) + w2 * bflo(cv.y); o[0][3] = w0 * bfhi(a0.y) + w2 * bfhi(cv.y);
          o[1][0] = w0 * bflo(a1.x) + w2 * bflo(cv.z); o[1][1] = w0 * bfhi(a1.x) + w2 * bfhi(cv.z); o[1][2] = w0 * bflo(a1.y) + w2 * bflo(cv.w); o[1][3] = w0 * bfhi(a1.y) + w2 * bfhi(cv.w);
          *(bf16x8*)(yp + 8 * c) = pack8(o[0], o[1]); } }
    __syncthreads();
}

constexpr int XA_KROW = 528;
static_assert(256 * XA_KROW <= LDS_BYTES - 64, "xattn lds");
__device__ __forceinline__ void xa_stage(LAS uchar* lds, const char* src, int pitch, int tid0) {
    int t = tid0; asm volatile("" : "+v"(t));
#pragma unroll
    for (int hb = 0; hb < 2; ++hb) { u32x4 r[8];
#pragma unroll
        for (int i = 0; i < 8; ++i) { const int c = t + 512 * (8 * hb + i), row = c >> 5, c16 = c & 31; r[i] = *(const u32x4*)(src + (unsigned)(row * pitch + c16 * 16)); }
#pragma unroll
        for (int i = 0; i < 8; ++i) { const int c = t + 512 * (8 * hb + i), row = c >> 5, c16 = c & 31; *(LAS u32x4*)(lds + row * XA_KROW + c16 * 16) = r[i]; } }
}
__device__ void xattn_wg(LAS uchar* lds, const Params& p, int layer, int su, int wb) {
    int tid = TIDX; asm volatile("" : "+v"(tid));
    const int lane = tid & 63, wid = __builtin_amdgcn_readfirstlane(tid >> 6);
    const int fr = lane & 15, g = lane >> 4;
    const int xj = su >> 3, b = 4 * (su & 7) + (xj >> 3), hx = (xj >> 1) & 3, half = xj & 1;
    const bf16_t* KX = (const bf16_t*)(p.ws + WS_KX) + ((size_t)layer * 8192 + (size_t)b * 256) * 1024 + hx * 256;
    const bf16_t* VT = (const bf16_t*)(p.ws + WS_VXT) + ((size_t)layer * 32 + b) * 1024 * 256 + (size_t)hx * 256 * 256;
    __syncthreads();
    xa_stage(lds, (const char*)KX, 2048, tid);
    __syncthreads();
    const LAS uchar* kbase = lds + fr * XA_KROW + 16 * g;
#pragma unroll 1
    for (int blk = 0; blk < 4; ++blk) {
        const int qb = half * 4 + blk;
        const bf16_t* qx = (const bf16_t*)(p.ws + WS_BIG) + ((size_t)b * SEQ + qb * 256 + wid * 32) * 1024 + hx * 256;
        bf16_t* OX = (bf16_t*)(p.ws + WS_Y) + ((size_t)b * SEQ + qb * 256 + wid * 32) * 1024 + hx * 256;
        f32x4 acc[2][16];
#pragma unroll
        for (int qt = 0; qt < 2; ++qt)
#pragma unroll
            for (int kt = 0; kt < 16; ++kt) acc[qt][kt] = (f32x4){0.f, 0.f, 0.f, 0.f};
#pragma unroll
        for (int kh = 0; kh < 2; ++kh) {
            bf16x8 qf[2][4];
#pragma unroll
            for (int qt = 0; qt < 2; ++qt)
#pragma unroll
                for (int ks = 0; ks < 4; ++ks) qf[qt][ks] = *(const bf16x8*)((const char*)qx + (unsigned)((16 * qt + fr) * 1024 + 32 * (4 * kh + ks) + 8 * g) * 2u);
            bf16x8 kfa[4], kfb[4];
#define XA_KLOAD(dst, kt) do { const LAS uchar* _kp = kbase + (kt) * 16 * XA_KROW; asm volatile("" : "+v"(_kp)); _Pragma("unroll") for (int ks = 0; ks < 4; ++ks) dst[ks] = *(const LAS bf16x8*)(_kp + (32 * (4 * kh + ks)) * 2); } while (0)
#define XA_KMMA(src, kt) do { __builtin_amdgcn_s_setprio(1); _Pragma("unroll") for (int ks = 0; ks < 4; ++ks) { acc[0][kt] = mfma16(src[ks], qf[0][ks], acc[0][kt]); acc[1][kt] = mfma16(src[ks], qf[1][ks], acc[1][kt]); } __builtin_amdgcn_s_setprio(0); } while (0)
            XA_KLOAD(kfa, 0);
#pragma unroll
            for (int kt = 0; kt < 16; kt += 2) {
                XA_KLOAD(kfb, kt + 1); __builtin_amdgcn_sched_barrier(0);
                XA_KMMA(kfa, kt); __builtin_amdgcn_sched_barrier(0);
                if (kt + 2 < 16) { XA_KLOAD(kfa, kt + 2); } __builtin_amdgcn_sched_barrier(0);
                XA_KMMA(kfb, kt + 1); __builtin_amdgcn_sched_barrier(0);
            }
#undef XA_KLOAD
#undef XA_KMMA
        }
        float inv[2];
        bf16x8 pk[2][8];
#pragma unroll
        for (int qt = 0; qt < 2; ++qt) { float mx = -__builtin_inff();
#pragma unroll
            for (int kt = 0; kt < 16; ++kt) mx = fmaxf(fmaxf(fmaxf(acc[qt][kt][0], acc[qt][kt][1]), fmaxf(acc[qt][kt][2], acc[qt][kt][3])), mx);
            mx = fmaxf(mx, __shfl_xor(mx, 16)); mx = fmaxf(mx, __shfl_xor(mx, 32));
            float ls = 0.f;
#pragma unroll
            for (int kt = 0; kt < 16; ++kt)
#pragma unroll
                for (int rg = 0; rg < 4; ++rg) { const float e = __builtin_amdgcn_exp2f(acc[qt][kt][rg] - mx); acc[qt][kt][rg] = e; ls += e; }
            ls += __shfl_xor(ls, 16); ls += __shfl_xor(ls, 32); inv[qt] = fast_rcp(ls);
#pragma unroll
            for (int ks = 0; ks < 8; ++ks) pk[qt][ks] = pack8(acc[qt][2 * ks], acc[qt][2 * ks + 1]); }
        __syncthreads();
        xa_stage(lds, (const char*)VT, 512, tid);
        __syncthreads();
#pragma unroll
        for (int dt = 0; dt < 16; ++dt) {
            bf16x8 vf[8];
            { const LAS uchar* _vb = kbase; asm volatile("" : "+v"(_vb)); const LAS uchar* _vp = _vb + dt * 16 * XA_KROW;
#pragma unroll
              for (int ks = 0; ks < 8; ++ks) vf[ks] = *(const LAS bf16x8*)(_vp + 64 * ks); }
            f32x4 o0 = (f32x4){0.f, 0.f, 0.f, 0.f}, o1 = (f32x4){0.f, 0.f, 0.f, 0.f};
            __builtin_amdgcn_s_setprio(1);
#pragma unroll
            for (int ks = 0; ks < 8; ++ks) { o0 = mfma16(vf[ks], pk[0][ks], o0); o1 = mfma16(vf[ks], pk[1][ks], o1); }
            __builtin_amdgcn_s_setprio(0);
            u32x2 w0; w0.x = cvt_pk_bf16(o0[0] * inv[0], o0[1] * inv[0]); w0.y = cvt_pk_bf16(o0[2] * inv[0], o0[3] * inv[0]);
            u32x2 w1; w1.x = cvt_pk_bf16(o1[0] * inv[1], o1[1] * inv[1]); w1.y = cvt_pk_bf16(o1[2] * inv[1], o1[3] * inv[1]);
            unsigned oo = (unsigned)(fr * 1024 + 16 * dt + 4 * g) * 2u; asm volatile("" : "+v"(oo));
            *(u32x2*)((char*)OX + oo) = w0; *(u32x2*)((char*)OX + oo + 16 * 1024 * 2) = w1; }
        if (blk < 3) { __syncthreads(); xa_stage(lds, (const char*)KX, 2048, tid); __syncthreads(); }
    }
    __syncthreads();
}

#define XB_TMO      128
#define XB_XCNT(j)  (256  + 64 * (j))
#define XB_XSUB(j)  (1280 + 64 * (j))
#define XB_XGEN(j)  (2304 + 64 * (j))
#define XB_TOP      3328
#define XB_TOPGEN   3392
#define XCD_BAR_WORDS 3456
#define XB_SPIN_CAP (1u << 22)
__device__ __forceinline__ unsigned xb_ld(unsigned* p)              { return __hip_atomic_load(p, __ATOMIC_RELAXED, __HIP_MEMORY_SCOPE_AGENT); }
__device__ __forceinline__ unsigned xb_add(unsigned* p, unsigned v) { return __hip_atomic_fetch_add(p, v, __ATOMIC_RELAXED, __HIP_MEMORY_SCOPE_AGENT); }
__device__ __forceinline__ unsigned xb_xcc_id() { return (unsigned)__builtin_amdgcn_s_getreg((3 << 11) | 20) & 0xFu; }
#define XB_SPIN(cond, bar) do { unsigned _sp = 0; while (cond) { __builtin_amdgcn_s_sleep(1); \
    if ((++_sp & 255u) == 0u) { if (xb_ld(&(bar)[XB_TMO])) break; if (_sp > XB_SPIN_CAP) { atomicAdd(&(bar)[XB_TMO], 1u); break; } } } } while (0)
struct XcdBarrier { unsigned* bar; unsigned x; volatile LAS unsigned* st; };
__device__ __forceinline__ XcdBarrier xcd_barrier_post(unsigned* bar, volatile LAS unsigned* st, int wb) {
    XcdBarrier b; b.bar = bar; b.x = xb_xcc_id(); b.st = st;
    if (TIDX == 0) (void)xb_add(&bar[XB_XCNT(b.x)], 1u);
    return b;
}
__device__ __forceinline__ void xcd_barrier_complete(unsigned* bar, unsigned x, unsigned& nloc, unsigned& nx) {
    const unsigned G = gridDim.x * gridDim.y * gridDim.z;
    unsigned sum, cnt, mine, sp = 0u;
    for (;;) {
        sum = 0u; cnt = 0u; mine = 0u;
#pragma unroll
        for (unsigned j = 0; j < 16; ++j) { const unsigned c = xb_ld(&bar[XB_XCNT(j)]); sum += c; cnt += (c > 0u) ? 1u : 0u; mine = (j == x) ? c : mine; }
        if (sum == G) break;
        __builtin_amdgcn_s_sleep(1);
        if ((++sp & 255u) == 0u) { if (xb_ld(&bar[XB_TMO])) break; if (sp > XB_SPIN_CAP) { atomicAdd(&bar[XB_TMO], 1u); break; } }
    }
    nloc = mine > 0u ? mine : 1u; nx = cnt > 0u ? cnt : 1u;
}
__device__ __forceinline__ void xcd_barrier(const XcdBarrier& b, int wb) {
    asm volatile("s_waitcnt vmcnt(0)" ::: "memory");
    __syncthreads();
    if (TIDX == 0) {
        unsigned* bar = b.bar;
        __builtin_amdgcn_s_waitcnt(0);
        unsigned nloc = b.st[0], nx = b.st[1];
        if (nloc == 0u) { xcd_barrier_complete(bar, b.x, nloc, nx); b.st[0] = nloc; b.st[1] = nx; }
        const unsigned old = xb_add(&bar[XB_XSUB(b.x)], 1u);
        const unsigned gen = old / nloc;
        if (old + 1u == (gen + 1u) * nloc) {
            __builtin_amdgcn_fence(__ATOMIC_RELEASE, "agent");
            asm volatile("s_waitcnt vmcnt(0)" ::: "memory");
            const unsigned og = xb_add(&bar[XB_TOP], 1u);
            const unsigned tg = og / nx;
            if (og + 1u == (tg + 1u) * nx) xb_add(&bar[XB_TOPGEN], 1u);
            else XB_SPIN(xb_ld(&bar[XB_TOPGEN]) == tg, bar);
            __builtin_amdgcn_fence(__ATOMIC_ACQUIRE, "agent");
            xb_add(&bar[XB_XGEN(b.x)], 1u);
            asm volatile("s_waitcnt vmcnt(0)" ::: "memory");
        } else {
            XB_SPIN(xb_ld(&bar[XB_XGEN(b.x)]) == gen, bar);
            __builtin_amdgcn_fence(__ATOMIC_ACQUIRE, "agent");
            asm volatile("s_waitcnt vmcnt(0)" ::: "memory");
        }
    }
    __syncthreads();
}

#if PROBE_WHICH
#define TS_BEGIN(id) do { if ((id) == PROBE_WHICH) ts0 = __builtin_amdgcn_s_memrealtime(); } while (0)
#define TS_END(id) do { if ((id) == PROBE_WHICH) tacc += __builtin_amdgcn_s_memrealtime() - ts0; } while (0)
#else
#define TS_BEGIN(id) do {} while (0)
#define TS_END(id) do {} while (0)
#endif
__global__ void __launch_bounds__(512) fwd_megakernel(Params p) {
    extern __shared__ __attribute__((aligned(16))) uchar lds_raw[];
    LAS uchar* lds = (LAS uchar*)lds_raw;
    cg::grid_group grid = cg::this_grid();
    const int wb = __builtin_amdgcn_readfirstlane((int)threadIdx.x) & ~63;
    volatile LAS unsigned* xst = (volatile LAS unsigned*)(lds + LDS_BYTES - 32);
    if (TIDX == 0) { xst[0] = 0u; xst[1] = 0u; }
    __syncthreads();
    const int tid = TIDX, G = gridDim.x;
    uchar* ws = p.ws;
#if PROBE_WHICH
    unsigned long long ts0 = 0, tacc = 0;
#endif
    bf16_t* HB = (bf16_t*)(ws + WS_HB); bf16_t* BIG = (bf16_t*)(ws + WS_BIG); bf16_t* YB = (bf16_t*)(ws + WS_Y); bf16_t* MEMB = (bf16_t*)(ws + WS_MEMB);
    bf16_t* WB = (bf16_t*)(ws + WS_W); float* ROWSS = (float*)(ws + WS_ROWSS); float* MEMSS = (float*)(ws + WS_MEMSS); unsigned* CTR = (unsigned*)(ws + WS_CTR);

    TS_BEGIN(1);
    {
        int base = 0;
        for (int l = 0; l < 2; ++l) { bf16_t* W = WB + (size_t)l * W_LAYER;
            convert_weight(lds, p.w1g + (size_t)l * 1024 * 2816, 1024, 2816, W + W_GU1, 256, 0, p.ln_ffn1 + l * 1024, base, wb);
            convert_weight(lds, p.w1u + (size_t)l * 1024 * 2816, 1024, 2816, W + W_GU1, 256, 128, p.ln_ffn1 + l * 1024, base, wb);
            convert_weight(lds, p.w1d + (size_t)l * 2816 * 1024, 2816, 1024, W + W_D1, 128, 0, nullptr, base, wb);
            convert_weight(lds, p.w_in + (size_t)l * 1024 * 4096, 1024, 4096, W + W_IN, 128, 0, p.ln_mix + l * 1024, base, wb);
            convert_weight(lds, p.w_out + (size_t)l * 1024 * 1024, 1024, 1024, W + W_OUT, 128, 0, nullptr, base, wb);
            convert_weight(lds, p.w_xq + (size_t)l * 1024 * 1024, 1024, 1024, W + W_XQ, 128, 0, p.ln_xq + l * 1024, base, wb);
            convert_weight(lds, p.w_xkv + (size_t)l * 1024 * 2048, 1024, 2048, W + W_XKV, 128, 0, p.ln_mem + l * 1024, base, wb);
            convert_weight(lds, p.w_xo + (size_t)l * 1024 * 1024, 1024, 1024, W + W_XO, 128, 0, nullptr, base, wb);
            convert_weight(lds, p.w2g + (size_t)l * 1024 * 2816, 1024, 2816, W + W_GU2, 256, 0, p.ln_ffn2 + l * 1024, base, wb);
            convert_weight(lds, p.w2u + (size_t)l * 1024 * 2816, 1024, 2816, W + W_GU2, 256, 128, p.ln_ffn2 + l * 1024, base, wb);
            convert_weight(lds, p.w2d + (size_t)l * 2816 * 1024, 2816, 1024, W + W_D2, 128, 0, nullptr, base, wb); }
        convert_rows(p.x, HB, ROWSS, NTOK, wb);
        convert_rows(p.mem, MEMB, MEMSS, 8192, wb);
        if (blockIdx.x == 0 && tid < 64) CTR[tid] = 0u;
        if (blockIdx.x == 0) { unsigned* bw = (unsigned*)(p.ws + WS_BAR); for (int i = tid; i < 3456; i += 512) bw[i] = 0u; }
    }
    grid.sync();
    const XcdBarrier xbar = xcd_barrier_post((unsigned*)(p.ws + WS_BAR), xst, wb);
    TS_END(1);
    pg8::StaticOrder S;
    TS_BEGIN(2);
    for (int l = 0; l < 2; ++l) { S.init(8192, 2048, G, blockIdx.x);
        pg8::EpiMemKV E{(bf16_t*)(ws + WS_KX) + (size_t)l * 8192 * 1024, (bf16_t*)(ws + WS_VXT) + (size_t)l * 8192 * 1024, MEMSS};
        pg8::gemm_phase(lds, pg8::Gemm{MEMB, WB + (size_t)l * W_LAYER + W_XKV, 8192, 2048, 1024}, S, E, wb); }
    TS_END(2);

    for (int l = 0; l < 2; ++l) {
        const Params& pl = p;
        const bf16_t* W = WB + (size_t)l * W_LAYER;
        TS_BEGIN(3);
        { S.init(NTOK, 5632, G, blockIdx.x); pg8::EpiSwiglu E{BIG, ROWSS + (size_t)(4 * l + 0) * NTOK * 16};
          pg8::gemm_phase(lds, pg8::Gemm{HB, W + W_GU1, NTOK, 5632, 1024}, S, E, wb); }
        xcd_barrier(xbar, wb);
        TS_END(3); TS_BEGIN(4);
        { S.init(NTOK, 1024, G, blockIdx.x); pg8::EpiRes E{HB, ROWSS + (size_t)(4 * l + 1) * NTOK * 16, 0.5f};
          pg8::gemm_phase(lds, pg8::Gemm{BIG, W + W_D1, NTOK, 1024, 2816}, S, E, wb); }
        xcd_barrier(xbar, wb);
        TS_END(4); TS_BEGIN(5);
        { S.init(NTOK, 4096, G, blockIdx.x); pg8::EpiScale E{BIG, 4096, ROWSS + (size_t)(4 * l + 1) * NTOK * 16, 1.0f};
          pg8::gemm_phase(lds, pg8::Gemm{HB, W + W_IN, NTOK, 4096, 1024}, S, E, wb); }
        xcd_barrier(xbar, wb);
        TS_END(5); TS_BEGIN(6);
        {
#ifndef NO_HGRN
          TS_BEGIN(9);
          for (int u = blockIdx.x; u < 128; u += G) hgrn_unit(lds, pl, l, u, wb);
          TS_END(9);
#endif
          volatile LAS unsigned* bc = (volatile LAS unsigned*)(lds + LDS_BYTES - 16);
          int qtid = TIDX; asm volatile("" : "+v"(qtid));
          int seen_mask = 0;
          const int myq = (int)(xb_xcc_id() & 7u);
          for (int k = 0; k < 8; ++k) { const int q = (myq + k) & 7;
            for (;;) { if (qtid == 0) *bc = atomicAdd(CTR + l * 8 + q, 1u); __syncthreads(); const unsigned u = *bc; __syncthreads(); if (u >= 512u) break;
#ifndef NO_DATT
              unsigned* dn = CTR + 16 + l * 8 + q;
              if (u < 256u) dattn16_unit(lds, pl, q * 256 + (int)u, dn, wb);
              else { int seen = (seen_mask >> q) & 1; dattn_unit(lds, pl, q * 256 + (int)u - 256, dn, seen, wb); seen_mask |= seen << q; }
#endif
            } }
          }
        xcd_barrier(xbar, wb);
        TS_END(6); TS_BEGIN(7);
        { S.init(NTOK, 1024, G, blockIdx.x); pg8::EpiRes E{HB, ROWSS + (size_t)(4 * l + 2) * NTOK * 16, 1.0f};
          pg8::gemm_phase(lds, pg8::Gemm{YB, W + W_OUT, NTOK, 1024, 1024}, S, E, wb); }
        xcd_barrier(xbar, wb);
#ifndef NO_XATT
        for (int u = blockIdx.x; u < 256; u += G) {
            const int xj = u >> 3, xb = 4 * (u & 7) + (xj >> 3), xh = (xj >> 1) & 3, half = xj & 1;
            pg8::XqOrder XS{8 * xb + 4 * half, xh}; pg8::EpiScale E{BIG, 1024, ROWSS + (size_t)(4 * l + 2) * NTOK * 16, 0.0625f * 1.44269504089f};
            pg8::gemm_phase(lds, pg8::Gemm{HB, W + W_XQ, NTOK, 1024, 1024}, XS, E, wb);
            xattn_wg(lds, pl, l, u, wb); }
#endif
        xcd_barrier(xbar, wb);
        TS_END(8); TS_BEGIN(7);
        { S.init(NTOK, 1024, G, blockIdx.x); pg8::EpiRes E{HB, ROWSS + (size_t)(4 * l + 3) * NTOK * 16, 1.0f};
          pg8::gemm_phase(lds, pg8::Gemm{YB, W + W_XO, NTOK, 1024, 1024}, S, E, wb); }
        xcd_barrier(xbar, wb);
        TS_END(7); TS_BEGIN(3);
        { S.init(NTOK, 5632, G, blockIdx.x); pg8::EpiSwiglu E{BIG, ROWSS + (size_t)(4 * l + 3) * NTOK * 16};
          pg8::gemm_phase(lds, pg8::Gemm{HB, W + W_GU2, NTOK, 5632, 1024}, S, E, wb); }
        xcd_barrier(xbar, wb);
        TS_END(3); TS_BEGIN(4);
        { S.init(NTOK, 1024, G, blockIdx.x); pg8::EpiRes E{HB, ROWSS + (size_t)(4 * l + 4) * NTOK * 16, 0.5f};
          pg8::gemm_phase(lds, pg8::Gemm{BIG, W + W_D2, NTOK, 1024, 2816}, S, E, wb); }
#if PROBE_WHICH
        if (l == 1) { TS_END(4); if (blockIdx.x == (PROBE_WHICH >= 10 ? G - 1 : 0) && tid == 0) { CTR[32] = (unsigned)(tacc / 10ull); __threadfence(); } }
#endif
        xcd_barrier(xbar, wb);
#if PROBE_WHICH
        if (l == 0) TS_END(4);
#endif
    }
#if PROBE_WHICH
    final_norm(p.out, HB, ROWSS + (size_t)8 * NTOK * 16, p.ln_final, (size_t)CTR[32], wb);
#else
    final_norm(p.out, HB, ROWSS + (size_t)8 * NTOK * 16, p.ln_final, 0, wb);
#endif
}

extern "C" void kernel_launch(void* const* d_in, const int* in_sizes, int n_in, void* d_out, int out_size, void* d_ws, size_t ws_size, hipStream_t stream) {
    static int grid_blocks = 0;
    if (!grid_blocks) {
        int dev = 0, cus = 0, per_cu = 0;
        hipGetDevice(&dev);
        hipDeviceGetAttribute(&cus, hipDeviceAttributeMultiprocessorCount, dev);
        if (hipFuncSetAttribute((const void*)fwd_megakernel, hipFuncAttributeMaxDynamicSharedMemorySize, LDS_BYTES) != hipSuccess) fprintf(stderr, "hipFuncSetAttribute failed\n");
        hipOccupancyMaxActiveBlocksPerMultiprocessor(&per_cu, (const void*)fwd_megakernel, 512, LDS_BYTES);
        if (per_cu < 1) per_cu = 1;
        grid_blocks = cus * per_cu;
        if (ws_size < WS_END) fprintf(stderr, "workspace too small: %zu < %zu\n", ws_size, (size_t)WS_END);
    }
    Params p{};
    const float** pp = (const float**)&p;
    for (int i = 0; i < 21; ++i) pp[i] = (const float*)d_in[i];
    p.out = (float*)d_out; p.ws = (uchar*)d_ws;
    void* args[] = {&p};
    hipError_t e = hipLaunchCooperativeKernel((const void*)fwd_megakernel, dim3(grid_blocks), dim3(512), args, LDS_BYTES, stream);
    if (e != hipSuccess) fprintf(stderr, "cooperative launch failed: %s (grid %d)\n", hipGetErrorString(e), grid_blocks);
}
```
